# Optimizing an MI355X kernel written in HIP

```python
import math
import jax, jax.numpy as jnp
from jax import lax
import numpy as np

D_MODEL = 1024
BATCH = 8
SEQ = 2048
DEPTH = 1

PLE_DIM = 256

RWKV_HEAD = 64
RWKV_HEADS = D_MODEL // RWKV_HEAD
RWKV_WIDTH = RWKV_HEADS * RWKV_HEAD
DECAY_RANK = 64
ICL_RANK = 64
DECAY_SCALE = math.exp(-0.5)
GN_EPS = 64e-5

DIFF_HEAD = 64
DIFF_HEADS = D_MODEL // (2 * DIFF_HEAD)
DIFF_WIDTH = DIFF_HEADS * 2 * DIFF_HEAD
SUBLN_EPS = 1e-5
ROPE_THETA = 10000.0
Q_BLOCK = 128

NORM_EPS = 1e-6

SHIFT_SIZES = (RWKV_WIDTH, RWKV_WIDTH, RWKV_WIDTH, DECAY_RANK, ICL_RANK)
SHIFT_COLS = 3 * RWKV_WIDTH + DECAY_RANK + ICL_RANK
IN_SIZES = (SHIFT_COLS, DIFF_WIDTH, DIFF_WIDTH, DIFF_WIDTH, RWKV_WIDTH, DIFF_WIDTH, D_MODEL, D_MODEL)
IN_COLS = SHIFT_COLS + 4 * DIFF_WIDTH + RWKV_WIDTH + 2 * D_MODEL

kernel_name = "hybrid_rwkv7_diffattn_gated_block"


def _split_points(sizes):
    return [int(s) for s in np.cumsum(np.array(sizes))[:-1]]


def rmsnorm(x, g, eps):
    xf = x.astype(jnp.float32)
    y = xf * lax.rsqrt(jnp.mean(xf * xf, axis=-1, keepdims=True) + eps)
    return (y * g.astype(jnp.float32)).astype(x.dtype)


def token_shift(u, mix):
    prev = jnp.pad(u, ((0, 0), (1, 0), (0, 0)))[:, :-1]
    return u + (prev - u) * mix


def rope_tables(positions, dim):
    inv = ROPE_THETA ** (-jnp.arange(0, dim, 2, dtype=jnp.float32) / dim)
    ang = positions.astype(jnp.float32)[..., None] * inv
    return jnp.cos(ang), jnp.sin(ang)


def apply_rope(t, cos, sin):
    c = cos[:, :, None, None, :]
    s = sin[:, :, None, None, :]
    tf = t.astype(jnp.float32)
    t1, t2 = jnp.split(tf, 2, axis=-1)
    return jnp.concatenate([t1 * c - t2 * s, t2 * c + t1 * s], axis=-1).astype(t.dtype)


def rwkv7_time_mix(r, k, v, wd, ad, w0, w_up, a0, a_up, k_k, k_a, r_k, gn_g, gn_b):
    B_, S_, _ = r.shape
    H, N = RWKV_HEADS, RWKV_HEAD
    f32 = jnp.float32
    logw = -DECAY_SCALE * jax.nn.sigmoid((w0 + jnp.tanh(wd) @ w_up).astype(f32))
    a = jax.nn.sigmoid((a0 + ad @ a_up).astype(f32))
    hs = lambda t: t.astype(f32).reshape(B_, S_, H, N)
    r, k, v, logw, a = hs(r), hs(k), hs(v), hs(logw), hs(a)
    kk = k * k_k.astype(f32).reshape(H, N)
    kk = kk * lax.rsqrt(jnp.sum(kk * kk, axis=-1, keepdims=True) + 1e-12)
    k = k * (1.0 + (a - 1.0) * k_a.astype(f32).reshape(H, N))
    decay = jnp.exp(logw)

    def step(state, inp):
        r_t, w_t, k_t, v_t, kk_t, a_t = inp
        sa = jnp.einsum('bhij,bhj->bhi', state, -kk_t)
        state = (state * w_t[:, :, None, :]
                 + sa[..., None] * (kk_t * a_t)[:, :, None, :]
                 + v_t[..., None] * k_t[:, :, None, :])
        return state, jnp.einsum('bhij,bhj->bhi', state, r_t)

    tm = lambda t: jnp.swapaxes(t, 0, 1)
    s0 = jnp.zeros((B_, H, N, N), f32)
    _, y = lax.scan(step, s0, (tm(r), tm(decay), tm(k), tm(v), tm(kk), tm(a)))
    y = tm(y)
    mu = jnp.mean(y, axis=-1, keepdims=True)
    var = jnp.mean(jnp.square(y - mu), axis=-1, keepdims=True)
    y = (y - mu) * lax.rsqrt(var + GN_EPS)
    y = y * gn_g.astype(f32).reshape(H, N) + gn_b.astype(f32).reshape(H, N)
    y = y + jnp.sum(r * k * r_k.astype(f32).reshape(H, N), axis=-1, keepdims=True) * v
    return y.reshape(B_, S_, RWKV_WIDTH)


def diff_attention(q, k, v, cos, sin, lam_vecs, subln_g, lambda_init):
    B_, S_, _ = q.shape
    H, d = DIFF_HEADS, DIFF_HEAD
    q = apply_rope(q.reshape(B_, S_, H, 2, d), cos, sin) * (d ** -0.5)
    k = apply_rope(k.reshape(B_, S_, H, 2, d), cos, sin)
    v = v.reshape(B_, S_, H, 2 * d)
    lv = lam_vecs.astype(jnp.float32)
    lam = jnp.exp(jnp.sum(lv[0] * lv[1])) - jnp.exp(jnp.sum(lv[2] * lv[3])) + lambda_init
    outs = []
    for qs in range(0, S_, Q_BLOCK):
        qe = qs + Q_BLOCK
        s = jnp.einsum('bqhcd,bkhcd->bhcqk', q[:, qs:qe], k[:, :qe]).astype(jnp.float32)
        causal = jnp.arange(qs, qe)[:, None] >= jnp.arange(qe)[None, :]
        pr = jax.nn.softmax(jnp.where(causal, s, -jnp.inf), axis=-1)
        attn = pr[:, :, 0] - lam * pr[:, :, 1]
        outs.append(jnp.einsum('bhqk,bkhd->bqhd', attn.astype(v.dtype), v[:, :qe]))
    o = jnp.concatenate(outs, axis=1)
    o = rmsnorm(o, subln_g, SUBLN_EPS) * (1.0 - lambda_init)
    return o.reshape(B_, S_, DIFF_WIDTH)


def setup_inputs(seed: int = 0) -> dict:
    key = jax.random.key(seed)
    ks = jax.random.split(key, 24)
    f32 = jnp.float32
    nrm = lambda k_, shp, sc: jax.random.normal(k_, shp, f32) * sc
    L, D, C = DEPTH, D_MODEL, RWKV_WIDTH
    return {
        "x": nrm(ks[0], (BATCH, SEQ, D), 1.0),
        "p": nrm(ks[1], (DEPTH, BATCH, SEQ, PLE_DIM), 1.0),
        "positions": (jax.random.randint(ks[2], (BATCH, 1), 0, 1024, jnp.int32)
                      + jnp.arange(SEQ, dtype=jnp.int32)[None, :]),
        "norm_g": 1.0 + nrm(ks[3], (L, D), 0.02),
        "w_in": nrm(ks[4], (L, D, IN_COLS), D ** -0.5),
        "shift_mix": jax.random.uniform(ks[5], (L, SHIFT_COLS), f32),
        "rwkv_w0": jax.random.uniform(ks[6], (L, C), f32, -6.0, 1.0),
        "rwkv_w_up": nrm(ks[7], (L, DECAY_RANK, C), 0.5 * DECAY_RANK ** -0.5),
        "rwkv_a0": nrm(ks[8], (L, C), 0.1),
        "rwkv_a_up": nrm(ks[9], (L, ICL_RANK, C), 0.5 * ICL_RANK ** -0.5),
        "rwkv_k_k": 0.85 + nrm(ks[10], (L, C), 0.02),
        "rwkv_k_a": 1.0 + nrm(ks[11], (L, C), 0.02),
        "rwkv_r_k": nrm(ks[12], (L, C), 0.1),
        "rwkv_gn_g": 1.0 + nrm(ks[13], (L, C), 0.02),
        "rwkv_gn_b": nrm(ks[14], (L, C), 0.02),
        "diff_lam": nrm(ks[15], (L, 4, DIFF_HEAD), 0.1),
        "diff_subln_g": 1.0 + nrm(ks[16], (L, 2 * DIFF_HEAD), 0.02),
        "w_branch": nrm(ks[17], (L, 2, C, D), C ** -0.5),
        "w_out": nrm(ks[18], (L, D, D), D ** -0.5),
        "ple_norm_g": 1.0 + nrm(ks[19], (L, D), 0.02),
        "w_ple_gate": nrm(ks[20], (L, D, D), D ** -0.5),
        "w_ple": nrm(ks[21], (L, PLE_DIM, D), PLE_DIM ** -0.5),
        "final_norm_g": 1.0 + nrm(ks[22], (D,), 0.02),
    }


def reference(x, p, positions, norm_g, w_in, shift_mix, rwkv_w0, rwkv_w_up, rwkv_a0, rwkv_a_up,
              rwkv_k_k, rwkv_k_a, rwkv_r_k, rwkv_gn_g, rwkv_gn_b, diff_lam, diff_subln_g,
              w_branch, w_out, ple_norm_g, w_ple_gate, w_ple, final_norm_g):
    cos, sin = rope_tables(positions, DIFF_HEAD)
    in_pts = _split_points(IN_SIZES)
    shift_pts = _split_points(SHIFT_SIZES)
    for i in range(DEPTH):
        lambda_init = 0.8 - 0.6 * math.exp(-0.3 * i)
        h = rmsnorm(x, norm_g[i], NORM_EPS)
        z = h @ w_in[i]
        zs, q, k, v, gate_a, gate_b, merge_a, merge_b = jnp.split(z, in_pts, axis=-1)
        zs = token_shift(zs, shift_mix[i])
        r_a, k_a, v_a, wd, ad = jnp.split(zs, shift_pts, axis=-1)
        y_a = rwkv7_time_mix(r_a, k_a, v_a, wd, ad, rwkv_w0[i], rwkv_w_up[i], rwkv_a0[i],
                             rwkv_a_up[i], rwkv_k_k[i], rwkv_k_a[i], rwkv_r_k[i],
                             rwkv_gn_g[i], rwkv_gn_b[i]).astype(x.dtype)
        y_a = y_a * jax.nn.silu(gate_a)
        y_b = diff_attention(q, k, v, cos, sin, diff_lam[i], diff_subln_g[i], lambda_init)
        y_b = y_b * jax.nn.silu(gate_b)
        m = (jax.nn.sigmoid(merge_a) * (y_a @ w_branch[i, 0])
             + jax.nn.sigmoid(merge_b) * (y_b @ w_branch[i, 1]))
        x = x + m @ w_out[i]
        hp = rmsnorm(x, ple_norm_g[i], NORM_EPS)
        x = x + jax.nn.sigmoid(hp @ w_ple_gate[i]) * (p[i] @ w_ple[i])
    return rmsnorm(x, final_norm_g, NORM_EPS)
```

```cpp
#include <hip/hip_runtime.h>
#include <hip/hip_cooperative_groups.h>
#include <cstdio>
#include <cstdint>
namespace cg = cooperative_groups;

constexpr int NB = 8, SEQ = 2048, DM = 1024, MTOK = NB * SEQ;
constexpr int INC = 10368;
constexpr int PLE = 256;
constexpr int ZP = 5376;
constexpr int N1 = 6400;
constexpr int N2 = 4096;
constexpr int ZC_Q = 0, ZC_K = 1024, ZC_R = 2048, ZC_KA = 3072, ZC_VA = 4096, ZC_WD = 5120, ZC_AD = 5184;
constexpr float QSCALE = 0.125f * 1.4426950408889634f;
constexpr float LAMBDA_INIT = 0.2f;

namespace pg8 {
#define PG8_LAS __attribute__((address_space(3)))
typedef unsigned short bf16_t;
typedef short bf16x8 __attribute__((ext_vector_type(8)));
typedef float f32x4 __attribute__((ext_vector_type(4)));
typedef unsigned u32x4 __attribute__((ext_vector_type(4)));
constexpr int BM = 256, BK = 64, HALF = 128, HTB = HALF * BK * 2  , STAGE_BYTES = 8 * HTB, NXCD = 8, WGM = 8;

__host__ __device__ __forceinline__ int lds_byte(int r, int c) { const int st = (r >> 4) * 2 + (c >> 5), rr = r & 15, cc = c & 31, ob = rr * 64 + cc * 2; return st * 1024 + (ob ^ (((ob >> 9) & 1) << 5)); }
__host__ __device__ __forceinline__ void stage_rc(int b, int& R, int& C) { const int st = b / 1024, sb = b % 1024, swz = sb ^ (((sb >> 9) & 1) << 5); R = (st >> 1) * 16 + swz / 64; C = (st & 1) * 32 + (swz % 64) / 2; }
__host__ __device__ __forceinline__ int perm32(int rho) { const int n = rho >> 4, i = rho & 15; return 8 * (i >> 2) + 4 * n + (i & 3); }

struct Unit { int pm, pn; };
struct Gemm { const bf16_t* A; const bf16_t* Bt; int M, N, K, lda; };

struct StaticOrder {
    int nM, nN, nwg, G, c;
    __host__ __device__ void init(int M, int N, int G_, int c_) { nM = M / BM; nN = N / BM; nwg = nM * nN; G = G_; c = c_; }
    __host__ __device__ bool next(int i, Unit& u) const {
        const long L = (long)i * G + c; if (L >= nwg) return false;
        int wgid = (int)L; { const int q = nwg / NXCD, r = nwg % NXCD, xcd = wgid % NXCD, off = wgid / NXCD; wgid = (xcd < r ? xcd * (q + 1) : r * (q + 1) + (xcd - r) * q) + off; }
        const int nig = WGM * nN, gid = wgid / nig, fm = gid * WGM, gsz = (nM - fm) < WGM ? (nM - fm) : WGM;
        u.pm = fm + ((wgid % nig) % gsz); u.pn = (wgid % nig) / gsz; return true;
    }
    __device__ __forceinline__ void a_ready(const Unit&) const {}
    __device__ __forceinline__ void done(const Unit&) const {}
};

__device__ __forceinline__ unsigned cvt_pk_bf16(float lo, float hi) { unsigned r; asm volatile("v_cvt_pk_bf16_f32 %0, %1, %2" : "=v"(r) : "v"(lo), "v"(hi)); return r; }
typedef float f32x2 __attribute__((ext_vector_type(2)));
typedef unsigned u32x2 __attribute__((ext_vector_type(2)));
__device__ __forceinline__ float bf_lo(unsigned w) { return __uint_as_float(w << 16); }
__device__ __forceinline__ float bf_hi(unsigned w) { return __uint_as_float(w & 0xffff0000u); }
__device__ __forceinline__ float sigm(float v) { return 1.f / (1.f + __expf(-v)); }
__device__ __forceinline__ unsigned short f2bf1(float f) { unsigned u = __float_as_uint(f); return (unsigned short)((u + 0x7fffu + ((u >> 16) & 1u)) >> 16); }

struct EpiZ1 {
    static constexpr bool PERM = true, AFTER_DRAIN = false;
    bf16_t* Z; bf16_t* Vt; const float* cosT; const float* sinT;
    __device__ __forceinline__ void operator()(const f32x4 (&acc)[2][2][4][2], const Unit& u, int wr, int wc, int fr, int fq) const {
        const int pn = u.pn; const int row0 = u.pm * BM + wr * 64 + fr;
        if (pn >= 8 && pn < 12) {
            const int b = (u.pm * BM) / SEQ, t0 = (u.pm * BM) % SEQ + wr * 64 + fr;
#pragma unroll
            for (int ai = 0; ai < 2; ++ai)
#pragma unroll
                for (int m = 0; m < 4; ++m) { const int t = t0 + ai * HALF + m * 16;
#pragma unroll
                    for (int bj = 0; bj < 2; ++bj) { const int h = 2 * (pn - 8) + bj; bf16_t* vb = Vt + ((size_t)(b * 8 + h) * 128 + wc * 32 + 8 * fq) * SEQ + t;
#pragma unroll
                        for (int n = 0; n < 2; ++n)
#pragma unroll
                            for (int i = 0; i < 4; ++i) vb[(size_t)(4 * n + i) * SEQ] = f2bf1(acc[ai][bj][m][n][i]); } }
        } else {
            const int colbase = (pn < 8 ? pn : pn - 4) * BM + wc * 32 + 8 * fq;
            const bool rope = pn < 8; const float sc = pn < 4 ? QSCALE : 1.f; const int i0 = (wc & 1) * 16 + 4 * fq;
#pragma unroll
            for (int ai = 0; ai < 2; ++ai)
#pragma unroll
                for (int m = 0; m < 4; ++m) { const int row = row0 + ai * HALF + m * 16; bf16_t* rowp = Z + (size_t)row * ZP + colbase;
                    f32x4 c4 = {1.f, 1.f, 1.f, 1.f}, s4 = {0.f, 0.f, 0.f, 0.f};
                    if (rope) { c4 = *(const f32x4*)(cosT + (size_t)row * 32 + i0); s4 = *(const f32x4*)(sinT + (size_t)row * 32 + i0); }
#pragma unroll
                    for (int bj = 0; bj < 2; ++bj) { const f32x4 v0 = acc[ai][bj][m][0], v1 = acc[ai][bj][m][1];
                        f32x4 o0, o1;
                        o0[0] = v0[0] * c4[0] - v0[1] * s4[0]; o0[1] = v0[1] * c4[0] + v0[0] * s4[0];
                        o0[2] = v0[2] * c4[1] - v0[3] * s4[1]; o0[3] = v0[3] * c4[1] + v0[2] * s4[1];
                        o1[0] = v1[0] * c4[2] - v1[1] * s4[2]; o1[1] = v1[1] * c4[2] + v1[0] * s4[2];
                        o1[2] = v1[2] * c4[3] - v1[3] * s4[3]; o1[3] = v1[3] * c4[3] + v1[2] * s4[3];
                        o0 = o0 * sc; o1 = o1 * sc;
                        u32x4 w; w.x = cvt_pk_bf16(o0[0], o0[1]); w.y = cvt_pk_bf16(o0[2], o0[3]); w.z = cvt_pk_bf16(o1[0], o1[1]); w.w = cvt_pk_bf16(o1[2], o1[3]);
                        *(u32x4*)(rowp + bj * HALF) = w; } }
        }
    }
};

struct EpiGates {
    static constexpr bool PERM = true, AFTER_DRAIN = false;
    bf16_t* YA; bf16_t* Z;
    __device__ __forceinline__ void operator()(const f32x4 (&acc)[2][2][4][2], const Unit& u, int wr, int wc, int fr, int fq) const {
        const int pn = u.pn; const int row0 = u.pm * BM + wr * 64 + fr; const int cin = wc * 32 + 8 * fq;
        bf16_t* base; int pitch; const bool gate = pn < 8;
        if (pn < 4) { base = YA + pn * BM + cin; pitch = DM; }
        else { base = Z + (pn - 4) * BM + cin; pitch = ZP; }
#pragma unroll
        for (int ai = 0; ai < 2; ++ai)
#pragma unroll
            for (int m = 0; m < 4; ++m) { bf16_t* rowp = base + (size_t)(row0 + ai * HALF + m * 16) * pitch;
#pragma unroll
                for (int bj = 0; bj < 2; ++bj) { const f32x4 v0 = acc[ai][bj][m][0], v1 = acc[ai][bj][m][1];
                    float g[8] = {v0[0], v0[1], v0[2], v0[3], v1[0], v1[1], v1[2], v1[3]};
                    u32x4 w;
                    if (gate) { const u32x4 y = *(const u32x4*)(rowp + bj * HALF);
#pragma unroll
                        for (int i = 0; i < 8; ++i) g[i] = g[i] * sigm(g[i]);
                        w.x = cvt_pk_bf16(bf_lo(y.x) * g[0], bf_hi(y.x) * g[1]); w.y = cvt_pk_bf16(bf_lo(y.y) * g[2], bf_hi(y.y) * g[3]);
                        w.z = cvt_pk_bf16(bf_lo(y.z) * g[4], bf_hi(y.z) * g[5]); w.w = cvt_pk_bf16(bf_lo(y.w) * g[6], bf_hi(y.w) * g[7]);
                    } else {
#pragma unroll
                        for (int i = 0; i < 8; ++i) g[i] = sigm(g[i]);
                        w.x = cvt_pk_bf16(g[0], g[1]); w.y = cvt_pk_bf16(g[2], g[3]); w.z = cvt_pk_bf16(g[4], g[5]); w.w = cvt_pk_bf16(g[6], g[7]);
                    }
                    *(u32x4*)(rowp + bj * HALF) = w; } }
    }
};

template <int MODE> struct EpiBranch {
    static constexpr bool PERM = true, AFTER_DRAIN = false;
    bf16_t* T; const bf16_t* Z; int smcol;
    __device__ __forceinline__ void operator()(const f32x4 (&acc)[2][2][4][2], const Unit& u, int wr, int wc, int fr, int fq) const {
        const int row0 = u.pm * BM + wr * 64 + fr; const int col0 = u.pn * BM + wc * 32 + 8 * fq;
#pragma unroll
        for (int ai = 0; ai < 2; ++ai)
#pragma unroll
            for (int m = 0; m < 4; ++m) { const int row = row0 + ai * HALF + m * 16; bf16_t* tp = T + (size_t)row * DM + col0; const bf16_t* sp = Z + (size_t)row * ZP + smcol + col0;
#pragma unroll
                for (int bj = 0; bj < 2; ++bj) { const f32x4 v0 = acc[ai][bj][m][0], v1 = acc[ai][bj][m][1];
                    const u32x4 s = *(const u32x4*)(sp + bj * HALF);
                    float o[8] = {v0[0] * bf_lo(s.x), v0[1] * bf_hi(s.x), v0[2] * bf_lo(s.y), v0[3] * bf_hi(s.y), v1[0] * bf_lo(s.z), v1[1] * bf_hi(s.z), v1[2] * bf_lo(s.w), v1[3] * bf_hi(s.w)};
                    if (MODE == 1) { const u32x4 t = *(const u32x4*)(tp + bj * HALF);
                        o[0] += bf_lo(t.x); o[1] += bf_hi(t.x); o[2] += bf_lo(t.y); o[3] += bf_hi(t.y); o[4] += bf_lo(t.z); o[5] += bf_hi(t.z); o[6] += bf_lo(t.w); o[7] += bf_hi(t.w); }
                    u32x4 w; w.x = cvt_pk_bf16(o[0], o[1]); w.y = cvt_pk_bf16(o[2], o[3]); w.z = cvt_pk_bf16(o[4], o[5]); w.w = cvt_pk_bf16(o[6], o[7]);
                    *(u32x4*)(tp + bj * HALF) = w; } }
    }
};

template <int MODE> struct EpiF32 {
    static constexpr bool PERM = false, AFTER_DRAIN = false;
    float* C; const float* R;
    __device__ __forceinline__ void operator()(const f32x4 (&acc)[2][2][4][2], const Unit& u, int wr, int wc, int fr, int fq) const {
        const int row0 = u.pm * BM + wr * 64 + fr, col0 = u.pn * BM + wc * 32 + 4 * fq;
#pragma unroll
        for (int ai = 0; ai < 2; ++ai)
#pragma unroll
            for (int m = 0; m < 4; ++m) { const size_t off = (size_t)(row0 + ai * HALF + m * 16) * DM + col0;
#pragma unroll
                for (int bj = 0; bj < 2; ++bj)
#pragma unroll
                    for (int n = 0; n < 2; ++n) { const size_t o2 = off + bj * HALF + n * 16; f32x4 v = acc[ai][bj][m][n];
                        if (MODE == 1) v = v + *(const f32x4*)(R + o2);
                        if (MODE == 2) { const f32x4 r = *(const f32x4*)(R + o2), c = *(const f32x4*)(C + o2);
                            v[0] = c[0] + sigm(v[0]) * r[0]; v[1] = c[1] + sigm(v[1]) * r[1]; v[2] = c[2] + sigm(v[2]) * r[2]; v[3] = c[3] + sigm(v[3]) * r[3]; }
                        *(f32x4*)(C + o2) = v; } }
    }
};

template <class Epi, class Sched, bool ALIGN_EPI = false, bool SP2 = false>
__device__ __forceinline__ void gemm_phase(PG8_LAS unsigned char* lds, const Gemm g, const Sched& S, const Epi& E) {
    const int tid = threadIdx.x, wid = __builtin_amdgcn_readfirstlane(tid >> 6), lane = tid & 63, wr = wid >> 2, wc = wid & 3, fr = lane & 15, fq = lane >> 4;
    const int K = g.K, nt = K / BK;
    unsigned voffA[2], voffB[2];
#pragma unroll
    for (int i = 0; i < 2; ++i) { int R, C; stage_rc(tid * 16 + i * 8192, R, C); const int Rb = Epi::PERM ? ((R & ~31) + perm32(R & 31)) : R;
        voffA[i] = (unsigned)(R * g.lda + C) * 2u; voffB[i] = (unsigned)(Rb * K + C) * 2u; }
    const size_t kstep = (size_t)(BK * 2);
    const size_t hstepB = (size_t)HALF * K * 2, hstepA = (size_t)HALF * g.lda * 2;
    const size_t tstepA = 2 * hstepA, tstepB = 2 * hstepB;
    const unsigned ldsw = (unsigned)wid * 1024u;
    const int aoff = lds_byte(wr * 64 + fr, fq * 8), boff = lds_byte(wc * 32 + fr, fq * 8);
#define PG8_SA(b, h) (((b) * 2 + (h)) * HTB)
#define PG8_SB(b, h) ((4 + (b) * 2 + (h)) * HTB)
#define PG8_STAGE(bufoff, gbase, voff) do { _Pragma("unroll") for (int _i = 0; _i < 2; ++_i) \
        __builtin_amdgcn_global_load_lds((const unsigned*)((const char*)(gbase) + (voff)[_i]), (PG8_LAS unsigned*)(lds + (bufoff) + ldsw + _i * 8192), 16, 0, 0); } while (0)
#define PG8_LDA(dst, b, h) do { _Pragma("unroll") for (int m = 0; m < 4; ++m) _Pragma("unroll") for (int k = 0; k < 2; ++k) dst[m][k] = *(const PG8_LAS bf16x8*)(lds + PG8_SA(b, h) + aoff + m * 2048 + k * 1024); } while (0)
#define PG8_LDB(dst, b, h) do { _Pragma("unroll") for (int n = 0; n < 2; ++n) _Pragma("unroll") for (int k = 0; k < 2; ++k) dst[n][k] = *(const PG8_LAS bf16x8*)(lds + PG8_SB(b, h) + boff + n * 2048 + k * 1024); } while (0)
#define PG8_MMA(ai, bj, At, Bt) do { __builtin_amdgcn_s_setprio(1); _Pragma("unroll") for (int m = 0; m < 4; ++m) _Pragma("unroll") for (int n = 0; n < 2; ++n) _Pragma("unroll") for (int k = 0; k < 2; ++k) \
        acc[ai][bj][m][n] = __builtin_amdgcn_mfma_f32_16x16x32_bf16(Bt[n][k], At[m][k], acc[ai][bj][m][n], 0, 0, 0); __builtin_amdgcn_s_setprio(0); } while (0)
#define PG8_WAIT_V(n) asm volatile("s_waitcnt vmcnt(" #n ")" ::: "memory")
#define PG8_WAIT_L(n) asm volatile("s_waitcnt lgkmcnt(" #n ")" ::: "memory")
#define PG8_BAR __builtin_amdgcn_s_barrier()
#define PG8_SCHED __builtin_amdgcn_sched_barrier(0)
    Unit cur, nxt; int ui = 0;
    if (!S.next(0, cur)) return;
    f32x4 acc[2][2][4][2];
#pragma unroll
    for (int a = 0; a < 2; ++a)
#pragma unroll
        for (int b = 0; b < 2; ++b)
#pragma unroll
            for (int m = 0; m < 4; ++m)
#pragma unroll
                for (int n = 0; n < 2; ++n) acc[a][b][m][n] = (f32x4){0.f, 0.f, 0.f, 0.f};
    bf16x8 At[4][2], B0[2][2], B1[2][2];
    const char* cA = (const char*)g.A + (size_t)cur.pm * tstepA; const char* cB = (const char*)g.Bt + (size_t)cur.pn * tstepB;
    S.a_ready(cur);
    if constexpr (SP2) {
        PG8_STAGE(PG8_SB(0, 0), cB, voffB); PG8_STAGE(PG8_SB(0, 1), cB + hstepB, voffB); PG8_STAGE(PG8_SA(0, 0), cA, voffA); PG8_STAGE(PG8_SA(0, 1), cA + hstepA, voffA);
        if (wr == 1) PG8_BAR;
        PG8_WAIT_V(2); PG8_BAR;
        PG8_STAGE(PG8_SB(1, 0), cB + kstep, voffB); PG8_STAGE(PG8_SA(1, 0), cA + kstep, voffA); PG8_STAGE(PG8_SB(1, 1), cB + hstepB + kstep, voffB);
        PG8_WAIT_V(6); PG8_BAR;
    } else {
        PG8_STAGE(PG8_SB(0, 0), cB, voffB); PG8_STAGE(PG8_SA(0, 0), cA, voffA); PG8_STAGE(PG8_SB(0, 1), cB + hstepB, voffB); PG8_STAGE(PG8_SA(0, 1), cA + hstepA, voffA);
        if (wr == 1) PG8_BAR;
        PG8_WAIT_V(4); PG8_BAR;
        PG8_STAGE(PG8_SB(1, 0), cB + kstep, voffB); PG8_STAGE(PG8_SA(1, 0), cA + kstep, voffA); PG8_STAGE(PG8_SB(1, 1), cB + hstepB + kstep, voffB);
        PG8_WAIT_V(6); PG8_BAR;
    }
    for (;;) {
        const bool has_next = S.next(ui + 1, nxt);
        const char* nA = has_next ? (const char*)g.A + (size_t)nxt.pm * tstepA : cA; const char* nB = has_next ? (const char*)g.Bt + (size_t)nxt.pn * tstepB : cB;
        for (int t = 0; t < nt; t += 2) {
            const bool last = (t == nt - 2);
            const char* a1 = cA + (size_t)(t + 1) * kstep;
            const char* a2 = last ? nA : cA + (size_t)(t + 2) * kstep; const char* b2 = last ? nB : cB + (size_t)(t + 2) * kstep;
            const char* a3 = a2 + kstep; const char* b3 = b2 + kstep;
            if (last && has_next) S.a_ready(nxt);
            if constexpr (SP2) {
            PG8_LDB(B0, 0, 0); PG8_LDB(B1, 0, 1); PG8_SCHED; PG8_LDA(At, 0, 0); PG8_STAGE(PG8_SA(1, 1), a1 + hstepA, voffA);
            PG8_WAIT_V(8); PG8_WAIT_L(0); PG8_BAR; PG8_MMA(0, 0, At, B0); PG8_MMA(0, 1, At, B1); PG8_BAR; PG8_SCHED;
            PG8_LDA(At, 0, 1); PG8_STAGE(PG8_SB(0, 0), b2, voffB); PG8_STAGE(PG8_SB(0, 1), b2 + hstepB, voffB); PG8_STAGE(PG8_SA(0, 0), a2, voffA);
            PG8_WAIT_V(8); PG8_WAIT_L(0); PG8_BAR; PG8_MMA(1, 0, At, B0); PG8_MMA(1, 1, At, B1); PG8_BAR; PG8_SCHED;
            PG8_LDB(B0, 1, 0); PG8_LDB(B1, 1, 1); PG8_SCHED; PG8_LDA(At, 1, 0); PG8_STAGE(PG8_SA(0, 1), a2 + hstepA, voffA);
            PG8_WAIT_V(8); PG8_WAIT_L(0); PG8_BAR; PG8_MMA(0, 0, At, B0); PG8_MMA(0, 1, At, B1); PG8_BAR; PG8_SCHED;
            PG8_LDA(At, 1, 1); PG8_STAGE(PG8_SB(1, 0), b3, voffB); PG8_STAGE(PG8_SB(1, 1), b3 + hstepB, voffB); PG8_STAGE(PG8_SA(1, 0), a3, voffA);
            PG8_WAIT_V(8); PG8_WAIT_L(0); PG8_BAR; PG8_MMA(1, 0, At, B0); PG8_MMA(1, 1, At, B1); PG8_BAR; PG8_SCHED;
            } else {
            PG8_LDB(B0, 0, 0); PG8_SCHED; PG8_LDA(At, 0, 0); PG8_STAGE(PG8_SA(1, 1), a1 + hstepA, voffA);
            PG8_WAIT_L(8); PG8_BAR; PG8_WAIT_L(0); PG8_MMA(0, 0, At, B0); PG8_BAR; PG8_SCHED;
            PG8_LDB(B1, 0, 1); PG8_STAGE(PG8_SB(0, 0), b2, voffB);
            PG8_BAR; PG8_WAIT_L(0); PG8_MMA(0, 1, At, B1); PG8_BAR;
            PG8_LDA(At, 0, 1); PG8_STAGE(PG8_SA(0, 0), a2, voffA);
            PG8_BAR; PG8_WAIT_L(0); PG8_MMA(1, 0, At, B0); PG8_BAR; PG8_SCHED;
            PG8_STAGE(PG8_SB(0, 1), b2 + hstepB, voffB);
            PG8_WAIT_V(6); PG8_BAR; PG8_MMA(1, 1, At, B1); PG8_BAR;
            PG8_LDB(B0, 1, 0); PG8_SCHED; PG8_LDA(At, 1, 0); PG8_STAGE(PG8_SA(0, 1), a2 + hstepA, voffA);
            PG8_WAIT_L(8); PG8_BAR; PG8_WAIT_L(0); PG8_MMA(0, 0, At, B0); PG8_BAR; PG8_SCHED;
            PG8_LDB(B1, 1, 1); PG8_STAGE(PG8_SB(1, 0), b3, voffB);
            PG8_BAR; PG8_WAIT_L(0); PG8_MMA(0, 1, At, B1); PG8_BAR;
            PG8_LDA(At, 1, 1); PG8_STAGE(PG8_SA(1, 0), a3, voffA);
            PG8_BAR; PG8_WAIT_L(0); PG8_MMA(1, 0, At, B0); PG8_BAR; PG8_SCHED;
            PG8_STAGE(PG8_SB(1, 1), b3 + hstepB, voffB);
            PG8_WAIT_V(6); PG8_BAR; PG8_MMA(1, 1, At, B1); PG8_BAR;
            }
        }
        if constexpr (ALIGN_EPI) { if (wr == 0) PG8_BAR; }
        if constexpr (!Epi::AFTER_DRAIN) { E(acc, cur, wr, wc, fr, fq); S.done(cur); }
        if (!has_next) break;
#pragma unroll
        for (int a = 0; a < 2; ++a)
#pragma unroll
            for (int b = 0; b < 2; ++b)
#pragma unroll
                for (int m = 0; m < 4; ++m)
#pragma unroll
                    for (int n = 0; n < 2; ++n) acc[a][b][m][n] = (f32x4){0.f, 0.f, 0.f, 0.f};
        cur = nxt; cA = nA; cB = nB; ++ui;
        if constexpr (ALIGN_EPI) { if (wr == 1) PG8_BAR; }
    }
    PG8_WAIT_V(0);
    if constexpr (!ALIGN_EPI) { if (wr == 0) PG8_BAR; }
    PG8_BAR;
    if constexpr (Epi::AFTER_DRAIN) { E.fused(acc, cur, wr, wc, fr, fq, lds, wid, lane); S.done(cur); }
#undef PG8_SA
#undef PG8_SB
#undef PG8_STAGE
#undef PG8_LDA
#undef PG8_LDB
#undef PG8_MMA
#undef PG8_WAIT_V
#undef PG8_WAIT_L
#undef PG8_BAR
#undef PG8_SCHED
}
}

constexpr size_t MiB = 1u << 20;
constexpr size_t WS_CTL = 0, CTL_ZERO_BYTES = 65536;
constexpr size_t WS_WIN = 1 * MiB;
constexpr size_t WS_PA = 22 * MiB, WS_PB = 24 * MiB, WS_WO = 26 * MiB, WS_WPG = 28 * MiB, WS_WPE = 30 * MiB;
constexpr size_t WS_WUP = 30 * MiB + 512 * 1024, WS_AUP = WS_WUP + 128 * 1024;
constexpr size_t WS_COS = 31 * MiB, WS_SIN = 33 * MiB;
constexpr size_t WS_PBF = 35 * MiB;
constexpr size_t WS_Z = 44 * MiB;
constexpr size_t WS_VT = 212 * MiB;
constexpr size_t WS_END = 244 * MiB;
constexpr size_t WS_X1 = WS_Z, WS_PE = WS_Z + 64 * MiB;
static_assert(WS_Z + (size_t)MTOK * ZP * 2 <= WS_VT && WS_VT + (size_t)MTOK * DM * 2 <= WS_END && WS_END <= 256 * MiB, "ws map");
constexpr size_t DO_XN = 0, DO_YA = 32 * MiB;
constexpr int CW_ATT = 64;
constexpr int CW_BAR = 4096;
constexpr int MISC_OFF = 131072 + 320;

constexpr int NWAVES = 8;
constexpr int LDS_BYTES = 147456;

typedef unsigned short bf16;
typedef unsigned v4u __attribute__((ext_vector_type(4)));
typedef unsigned v2u __attribute__((ext_vector_type(2)));
typedef float f32x4 __attribute__((ext_vector_type(4)));
typedef float f32x16 __attribute__((ext_vector_type(16)));
typedef short bf16x8 __attribute__((ext_vector_type(8)));
typedef short s16x4 __attribute__((ext_vector_type(4)));
#define LDS_WAIT() asm volatile("s_waitcnt lgkmcnt(0)" ::: "memory")

__device__ __forceinline__ unsigned f2bf(float f) { unsigned u = __float_as_uint(f); return (u + 0x7fffu + ((u >> 16) & 1u)) >> 16; }
__device__ __forceinline__ unsigned pk2(float lo, float hi) { return f2bf(lo) | (f2bf(hi) << 16); }
__device__ __forceinline__ float bflo(unsigned w) { return __uint_as_float(w << 16); }
__device__ __forceinline__ float bfhi(unsigned w) { return __uint_as_float(w & 0xffff0000u); }
__device__ __forceinline__ float wave_sum(float v) {
#pragma unroll
    for (int o = 1; o < 64; o <<= 1) v += __shfl_xor(v, o);
    return v;
}
template <int CTRL> __device__ __forceinline__ float dppf(float x) { return __builtin_bit_cast(float, __builtin_amdgcn_update_dpp(0, __builtin_bit_cast(int, x), CTRL, 0xf, 0xf, true)); }
__device__ __forceinline__ float red8(float x) { x += dppf<0xB1>(x); x += dppf<0x4E>(x); x += dppf<0x141>(x); return x; }
__device__ __forceinline__ float red16(float x) { x = red8(x); x += dppf<0x140>(x); return x; }
__device__ __forceinline__ int crow(int r, int hi) { return (r & 3) + 8 * (r >> 2) + 4 * hi; }

struct Args {
    const float *x, *p; const int* pos; const float *norm_g, *w_in, *shift_mix, *w0, *w_up, *a0, *a_up, *k_k, *k_a, *r_k, *gn_g, *gn_b, *diff_lam, *subln_g, *w_branch, *w_out, *ple_norm_g, *w_pg, *w_pe, *final_g;
    float* out; unsigned char* ws; int ph_lo, ph_hi, coop, pad;
};

__device__ __forceinline__ int win_row(int n) {
    if (n < 3072) return 3072 + n;
    if (n < 3200) return 6144 + (n - 3072);
    if (n < 5248) { const int j = n - 3200; return (j & ~63) + 2 * (j & 31) + ((j >> 5) & 1); }
    if (n < 6272) return 2048 + (n - 5248);
    return N1 + (n - 6272);
}
template <bool WIN> __device__ __forceinline__ void p0_transpose_item(const float* W, int Nsrc, int K, bf16* WT, __attribute__((address_space(3))) float* scr, int kb, int nb, int lane) {
    const int k0 = 64 * kb, n0 = 32 * nb;
#pragma unroll 8
    for (int i = 0; i < 32; ++i) { const int kk = 2 * i + (lane >> 5); scr[kk * 33 + (lane & 31)] = W[(size_t)(k0 + kk) * Nsrc + n0 + (lane & 31)]; }
    LDS_WAIT(); asm volatile("" ::: "memory");
    const int c = lane & 7;
#pragma unroll
    for (int j = 0; j < 4; ++j) { const int n = (lane >> 3) + 8 * j; const __attribute__((address_space(3))) float* s = scr + (8 * c) * 33 + n;
        v4u o; o.x = pk2(s[0 * 33], s[1 * 33]); o.y = pk2(s[2 * 33], s[3 * 33]); o.z = pk2(s[4 * 33], s[5 * 33]); o.w = pk2(s[6 * 33], s[7 * 33]);
        const int drow = WIN ? win_row(n0 + n) : (n0 + n);
        *(v4u*)(WT + (size_t)drow * K + k0 + 8 * c) = o; }
    LDS_WAIT(); asm volatile("" ::: "memory");
}
__device__ __forceinline__ void rms_row_to_bf16(const float* xrow, const float* g, bf16* orow, int lane) {
    const f32x4* xr = (const f32x4*)xrow + lane; const f32x4* gr = (const f32x4*)g + lane;
    f32x4 v[4]; float s = 0.f;
#pragma unroll
    for (int j = 0; j < 4; ++j) { v[j] = xr[64 * j]; s += (v[j].x * v[j].x + v[j].y * v[j].y) + (v[j].z * v[j].z + v[j].w * v[j].w); }
    const float rstd = 1.f / sqrtf(wave_sum(s) * (1.f / DM) + 1e-6f);
    unsigned long long* o8 = (unsigned long long*)orow + lane;
#pragma unroll
    for (int j = 0; j < 4; ++j) { const f32x4 gg = gr[64 * j]; o8[64 * j] = (unsigned long long)pk2(v[j].x * rstd * gg.x, v[j].y * rstd * gg.y) | ((unsigned long long)pk2(v[j].z * rstd * gg.z, v[j].w * rstd * gg.w) << 32); }
}
__device__ __forceinline__ void rms_row_to_f32(const float* xrow, const float* g, float* orow, int lane) {
    const f32x4* xr = (const f32x4*)xrow + lane; const f32x4* gr = (const f32x4*)g + lane;
    f32x4 v[4]; float s = 0.f;
#pragma unroll
    for (int j = 0; j < 4; ++j) { v[j] = xr[64 * j]; s += (v[j].x * v[j].x + v[j].y * v[j].y) + (v[j].z * v[j].z + v[j].w * v[j].w); }
    const float rstd = 1.f / sqrtf(wave_sum(s) * (1.f / DM) + 1e-6f);
    f32x4* o = (f32x4*)orow + lane;
#pragma unroll
    for (int j = 0; j < 4; ++j) { const f32x4 gg = gr[64 * j]; o[64 * j] = v[j] * rstd * gg; }
}

__device__ __forceinline__ void p0_prologue(const Args& A, unsigned char* ldsraw, int G, int bid) {
    const int tid = threadIdx.x, lane = tid & 63, wave = __builtin_amdgcn_readfirstlane(tid >> 6);
    __attribute__((address_space(3))) float* scr = (__attribute__((address_space(3))) float*)((__attribute__((address_space(3))) unsigned char*)ldsraw + wave * 16384);
    const int gw = bid * NWAVES + wave, NGW = G * NWAVES;
    unsigned char* ws = A.ws;
    bf16* WIN_T = (bf16*)(ws + WS_WIN);
    constexpr int I_IN = 16 * 324, I_SQ = 16 * 32, I_PE = 4 * 32, I_LR = 32;
    constexpr int NITEMS = I_IN + 4 * I_SQ + I_PE + 2 * I_LR;
    for (int it = gw; it < NITEMS; it += NGW) {
        int r = it;
        if (r < I_IN) { p0_transpose_item<true>(A.w_in, INC, DM, WIN_T, scr, r / 324, r % 324, lane); continue; } r -= I_IN;
        if (r < I_SQ) { p0_transpose_item<false>(A.w_branch, DM, DM, (bf16*)(ws + WS_PA), scr, r / 32, r % 32, lane); continue; } r -= I_SQ;
        if (r < I_SQ) { p0_transpose_item<false>(A.w_branch + (size_t)DM * DM, DM, DM, (bf16*)(ws + WS_PB), scr, r / 32, r % 32, lane); continue; } r -= I_SQ;
        if (r < I_SQ) { p0_transpose_item<false>(A.w_out, DM, DM, (bf16*)(ws + WS_WO), scr, r / 32, r % 32, lane); continue; } r -= I_SQ;
        if (r < I_SQ) { p0_transpose_item<false>(A.w_pg, DM, DM, (bf16*)(ws + WS_WPG), scr, r / 32, r % 32, lane); continue; } r -= I_SQ;
        if (r < I_PE) { p0_transpose_item<false>(A.w_pe, DM, PLE, (bf16*)(ws + WS_WPE), scr, r / 32, r % 32, lane); continue; } r -= I_PE;
        if (r < I_LR) { p0_transpose_item<false>(A.w_up, DM, 64, (bf16*)(ws + WS_WUP), scr, 0, r, lane); continue; } r -= I_LR;
        p0_transpose_item<false>(A.a_up, DM, 64, (bf16*)(ws + WS_AUP), scr, 0, r, lane);
    }
    { const int gt = bid * (NWAVES * 64) + tid, NT = G * NWAVES * 64; v4u z = {0u, 0u, 0u, 0u};
      for (int i = gt; i < 128 * 128; i += NT) *((v4u*)(WIN_T + (size_t)6272 * DM) + i) = z; }
    bf16* XN = (bf16*)((unsigned char*)A.out + DO_XN);
    for (int m = gw; m < MTOK; m += NGW) rms_row_to_bf16(A.x + (size_t)m * DM, A.norm_g, XN + (size_t)m * DM, lane);
    { const int gt = bid * (NWAVES * 64) + tid, NT = G * NWAVES * 64; v2u* o = (v2u*)(ws + WS_PBF); const f32x4* pi = (const f32x4*)A.p;
      for (int i = gt; i < MTOK * PLE / 4; i += NT) { const f32x4 v = pi[i]; v2u w; w.x = pk2(v.x, v.y); w.y = pk2(v.z, v.w); o[i] = w; } }
    { const int gt = bid * (NWAVES * 64) + tid, NT = G * NWAVES * 64; float* ct = (float*)(ws + WS_COS); float* st = (float*)(ws + WS_SIN);
      for (int i = gt; i < MTOK * 32; i += NT) { const int tok = i >> 5, f = i & 31; double invd = 1.0; for (int k = 0; k < f; ++k) invd *= 0.7498942093324559;
          const float inv = (float)invd; const float ang = (float)A.pos[tok] * inv;
          const double rev = (double)ang * 0.15915494309189535; const float fr = (float)(rev - __builtin_rint(rev));
          ct[i] = __builtin_amdgcn_cosf(fr); st[i] = __builtin_amdgcn_sinf(fr); } }
}

namespace att {
constexpr int KPB = 144;
constexpr int KBUF = 2 * 64 * KPB;
constexpr int VBUF = 128 * KPB;
constexpr int OFF_V = 2 * KBUF;
constexpr int OFF_WS = OFF_V + 2 * VBUF;
constexpr int OFF_Q = OFF_WS + 2048;
__device__ __forceinline__ void attn_unit(unsigned char* lds, const bf16* Z, const bf16* Vt, bf16* YB, int b, int h, int qb, float lam, const float* subln_g) {
    const int tid = threadIdx.x, lane = tid & 63, r32 = lane & 31, hi = lane >> 5; const int wid = __builtin_amdgcn_readfirstlane(tid >> 6);
    const int c = wid >> 2, wq = wid & 3;
    const int q0 = qb * 128, rq0 = q0 + wq * 32, nT = 2 * qb + 2;
    const size_t rowbase = (size_t)b * SEQ;
    float* wscr = (float*)(lds + OFF_WS) + wid * 64;
    bf16x8 qf[4];
    { const bf16* qp = Z + (rowbase + rq0 + r32) * ZP + ZC_Q + h * 128 + c * 64 + hi * 8;
#pragma unroll
      for (int s = 0; s < 4; ++s) qf[s] = *(const bf16x8*)(qp + 16 * s); }
    const int krow = (tid >> 3) & 63, kch = tid & 7;
    const bf16* ksrc = Z + (rowbase + krow) * ZP + ZC_K + h * 128 + kch * 8;
    const int vdv = tid >> 3, vch = tid & 7;
    const bf16* vsrc = Vt + ((size_t)(b * 8 + h) * 128 + vdv) * SEQ + vch * 8;
    v4u kr[2], vr[2];
#define ATT_GLOAD(t) do { const size_t ko = (size_t)(t) * 64 * ZP; kr[0] = *(const v4u*)(ksrc + ko); kr[1] = *(const v4u*)(ksrc + ko + 64); \
        vr[0] = *(const v4u*)(vsrc + (t) * 64); vr[1] = *(const v4u*)(vsrc + (size_t)64 * SEQ + (t) * 64); } while (0)
#define ATT_LSTORE(buf) do { *(v4u*)(lds + (buf) * KBUF + krow * KPB + kch * 16) = kr[0]; *(v4u*)(lds + (buf) * KBUF + 64 * KPB + krow * KPB + kch * 16) = kr[1]; \
        *(v4u*)(lds + OFF_V + (buf) * VBUF + vdv * KPB + vch * 16) = vr[0]; *(v4u*)(lds + OFF_V + (buf) * VBUF + (vdv + 64) * KPB + vch * 16) = vr[1]; } while (0)
    f32x16 o[4];
#pragma unroll
    for (int d = 0; d < 4; ++d)
#pragma unroll
        for (int r = 0; r < 16; ++r) o[d][r] = 0.f;
    float m_run = -INFINITY, l_run = 0.f;
    ATT_GLOAD(0); ATT_LSTORE(0); __syncthreads();
    for (int t = 0; t < nT; ++t) {
        const int buf = t & 1;
        if (t + 1 < nT) ATT_GLOAD(t + 1);
        const int kv0 = 64 * t;
        if (kv0 <= rq0 + 31) {
            f32x16 p0, p1;
#pragma unroll
            for (int r = 0; r < 16; ++r) { p0[r] = 0.f; p1[r] = 0.f; }
            const unsigned char* kb = lds + buf * KBUF + c * (64 * KPB) + r32 * KPB + hi * 16;
#pragma unroll
            for (int s = 0; s < 4; ++s) { const bf16x8 k0f = *(const bf16x8*)(kb + s * 32), k1f = *(const bf16x8*)(kb + 32 * KPB + s * 32);
                p0 = __builtin_amdgcn_mfma_f32_32x32x16_bf16(k0f, qf[s], p0, 0, 0, 0); p1 = __builtin_amdgcn_mfma_f32_32x32x16_bf16(k1f, qf[s], p1, 0, 0, 0); }
            if (kv0 + 63 > rq0) { const int q = rq0 + r32;
#pragma unroll
                for (int r = 0; r < 16; ++r) { const int kv = kv0 + crow(r, hi); if (kv > q) p0[r] = -INFINITY; if (kv + 32 > q) p1[r] = -INFINITY; } }
            float mx = fmaxf(p0[0], p1[0]);
#pragma unroll
            for (int r = 1; r < 16; ++r) mx = fmaxf(mx, fmaxf(p0[r], p1[r]));
            mx = fmaxf(mx, __shfl_xor(mx, 32));
            const float m_new = fmaxf(m_run, mx); const float alpha = __builtin_amdgcn_exp2f(m_run - m_new); m_run = m_new;
            float ls = 0.f;
#pragma unroll
            for (int r = 0; r < 16; ++r) { p0[r] = __builtin_amdgcn_exp2f(p0[r] - m_new); p1[r] = __builtin_amdgcn_exp2f(p1[r] - m_new); ls += p0[r] + p1[r]; }
            l_run = l_run * alpha + ls;
            asm volatile("" ::: "memory");
            if (hi == 0) wscr[r32] = alpha;
            LDS_WAIT();
#pragma unroll
            for (int r = 0; r < 16; ++r) { const float a = wscr[crow(r, hi)];
#pragma unroll
                for (int d = 0; d < 4; ++d) o[d][r] *= a; }
            asm volatile("" ::: "memory");
            bf16x8 pa[4];
#pragma unroll
            for (int s = 0; s < 2; ++s) { v4u w0, w1;
                w0.x = pk2(p0[8 * s + 0], p0[8 * s + 1]); w0.y = pk2(p0[8 * s + 2], p0[8 * s + 3]); w0.z = pk2(p0[8 * s + 4], p0[8 * s + 5]); w0.w = pk2(p0[8 * s + 6], p0[8 * s + 7]);
                w1.x = pk2(p1[8 * s + 0], p1[8 * s + 1]); w1.y = pk2(p1[8 * s + 2], p1[8 * s + 3]); w1.z = pk2(p1[8 * s + 4], p1[8 * s + 5]); w1.w = pk2(p1[8 * s + 6], p1[8 * s + 7]);
                pa[s] = __builtin_bit_cast(bf16x8, w0); pa[2 + s] = __builtin_bit_cast(bf16x8, w1); }
            const unsigned char* vb = lds + OFF_V + buf * VBUF + r32 * KPB + hi * 8;
#pragma unroll
            for (int d = 0; d < 4; ++d)
#pragma unroll
                for (int s = 0; s < 4; ++s) { const s16x4 lo = *(const s16x4*)(vb + d * 32 * KPB + s * 32), h4 = *(const s16x4*)(vb + d * 32 * KPB + s * 32 + 16);
                    const bf16x8 vf = {lo[0], lo[1], lo[2], lo[3], h4[0], h4[1], h4[2], h4[3]};
                    o[d] = __builtin_amdgcn_mfma_f32_32x32x16_bf16(pa[s], vf, o[d], 0, 0, 0); }
        }
        if (t + 1 < nT) ATT_LSTORE(buf ^ 1);
        __syncthreads();
    }
#undef ATT_GLOAD
#undef ATT_LSTORE
    { const float lt = l_run + __shfl_xor(l_run, 32);
      asm volatile("" ::: "memory");
      if (hi == 0) wscr[r32] = 1.f / lt;
      LDS_WAIT();
#pragma unroll
      for (int r = 0; r < 16; ++r) { const float a = wscr[crow(r, hi)];
#pragma unroll
          for (int d = 0; d < 4; ++d) o[d][r] *= a; }
      asm volatile("" ::: "memory"); }
    float* comb = (float*)lds + wq * (32 * 128);
    if (c == 1) {
#pragma unroll
        for (int r = 0; r < 16; ++r)
#pragma unroll
            for (int d = 0; d < 4; ++d) comb[crow(r, hi) * 128 + 32 * d + r32] = o[d][r];
    }
    __syncthreads();
    if (c == 0) {
        float g[4];
#pragma unroll
        for (int d = 0; d < 4; ++d) g[d] = subln_g[32 * d + r32] * (1.f - LAMBDA_INIT);
#pragma unroll
        for (int r = 0; r < 16; ++r) { const int qr = crow(r, hi); float dv[4]; float ss = 0.f;
#pragma unroll
            for (int d = 0; d < 4; ++d) { dv[d] = o[d][r] - lam * comb[qr * 128 + 32 * d + r32]; ss += dv[d] * dv[d]; }
            ss += __shfl_xor(ss, 1); ss += __shfl_xor(ss, 2); ss += __shfl_xor(ss, 4); ss += __shfl_xor(ss, 8); ss += __shfl_xor(ss, 16);
            const float rs = 1.f / sqrtf(ss * (1.f / 128.f) + 1e-5f);
            bf16* yp = YB + (rowbase + rq0 + qr) * ZP + ZC_Q + h * 128 + r32;
#pragma unroll
            for (int d = 0; d < 4; ++d) yp[32 * d] = (bf16)f2bf(dv[d] * rs * g[d]); }
    }
    __syncthreads();
}
}

namespace rwkv {
constexpr int CT = 32;
constexpr int A_SZ = CT * 64;
constexpr int OFF_SC = 7 * A_SZ, OFF_LW = OFF_SC + CT * 4, OFF_LA = OFF_LW + CT * 65, OFF_TW_F = OFF_LA + CT * 65;
__device__ __forceinline__ float sgm(float v) { return 1.f / (1.f + __expf(-v)); }
__device__ __forceinline__ void rwkv_head(unsigned char* lds, const Args& A, const bf16* Z, bf16* YA, int b, int h) {
    const int tid = threadIdx.x, lane = tid & 63, r32 = lane & 31, hi = lane >> 5; const int wid = __builtin_amdgcn_readfirstlane(tid >> 6);
    float* F = (float*)lds;
    float* sW = F, *sNKK = F + A_SZ, *sB = F + 2 * A_SZ, *sK = F + 3 * A_SZ, *sRW = F + 4 * A_SZ, *sV = F + 5 * A_SZ, *sY = F + 6 * A_SZ;
    float* sSc = F + OFF_SC; float* sLW = F + OFF_LW; float* sLA = F + OFF_LA;
    bf16* sTW = (bf16*)(F + OFF_TW_F); bf16* sAD = sTW + CT * 72;
    const bf16* WUPt = (const bf16*)(A.ws + WS_WUP); const bf16* AUPt = (const bf16*)(A.ws + WS_AUP);
    const int tok = tid >> 4, cg = tid & 15, c0 = 4 * cg, hc = h * 64 + c0;
    const f32x4 mix_r = *(const f32x4*)(A.shift_mix + hc), mix_k = *(const f32x4*)(A.shift_mix + 1024 + hc), mix_v = *(const f32x4*)(A.shift_mix + 2048 + hc);
    const f32x4 mix_w = *(const f32x4*)(A.shift_mix + 3072 + c0), mix_a = *(const f32x4*)(A.shift_mix + 3136 + c0);
    const f32x4 pw0 = *(const f32x4*)(A.w0 + hc), pa0 = *(const f32x4*)(A.a0 + hc), pkk = *(const f32x4*)(A.k_k + hc), pka = *(const f32x4*)(A.k_a + hc), prk = *(const f32x4*)(A.r_k + hc);
    const f32x4 pgg = *(const f32x4*)(A.gn_g + hc), pgb = *(const f32x4*)(A.gn_b + hc);
    bf16x8 wf[4];
    if (wid < 4) { const bf16* WT = (wid >> 1) ? AUPt : WUPt; const bf16* wp = WT + (size_t)(h * 64 + (wid & 1) * 32 + r32) * 64 + hi * 8;
#pragma unroll
        for (int s = 0; s < 4; ++s) wf[s] = *(const bf16x8*)(wp + 16 * s); }
    else {
#pragma unroll
        for (int s = 0; s < 4; ++s) wf[s] = (bf16x8){0, 0, 0, 0, 0, 0, 0, 0}; }
    const int si = 8 * wid + (lane >> 3), jb = lane & 7;
    float S[8];
#pragma unroll
    for (int j = 0; j < 8; ++j) S[j] = 0.f;
    const size_t rowbase = (size_t)b * SEQ;
    for (int t0 = 0; t0 < SEQ; t0 += CT) {
        const int t = t0 + tok; const bf16* zr = Z + (rowbase + t) * ZP;
        v2u cr = *(const v2u*)(zr + ZC_R + hc), ck = *(const v2u*)(zr + ZC_KA + hc), cv = *(const v2u*)(zr + ZC_VA + hc), cw = *(const v2u*)(zr + ZC_WD + c0), ca = *(const v2u*)(zr + ZC_AD + c0);
        v2u qr = {0u, 0u}, qk = {0u, 0u}, qv = {0u, 0u}, qw = {0u, 0u}, qa = {0u, 0u};
        if (t > 0) { const bf16* zp = zr - ZP; qr = *(const v2u*)(zp + ZC_R + hc); qk = *(const v2u*)(zp + ZC_KA + hc); qv = *(const v2u*)(zp + ZC_VA + hc); qw = *(const v2u*)(zp + ZC_WD + c0); qa = *(const v2u*)(zp + ZC_AD + c0); }
        float r[4], k[4], v[4], wd[4], ad[4];
#define SHF(dst, cur, prv, mix) do { const float u0 = bflo(cur.x), u1 = bfhi(cur.x), u2 = bflo(cur.y), u3 = bfhi(cur.y); \
        dst[0] = u0 + (bflo(prv.x) - u0) * mix[0]; dst[1] = u1 + (bfhi(prv.x) - u1) * mix[1]; dst[2] = u2 + (bflo(prv.y) - u2) * mix[2]; dst[3] = u3 + (bfhi(prv.y) - u3) * mix[3]; } while (0)
        SHF(r, cr, qr, mix_r); SHF(k, ck, qk, mix_k); SHF(v, cv, qv, mix_v); SHF(wd, cw, qw, mix_w); SHF(ad, ca, qa, mix_a);
#undef SHF
        { v2u w; w.x = pk2(tanhf(wd[0]), tanhf(wd[1])); w.y = pk2(tanhf(wd[2]), tanhf(wd[3])); *(v2u*)(sTW + tok * 72 + c0) = w;
          v2u a2; a2.x = pk2(ad[0], ad[1]); a2.y = pk2(ad[2], ad[3]); *(v2u*)(sAD + tok * 72 + c0) = a2; }
        __syncthreads();
        if (wid < 4) {
            const bf16* ap = ((wid >> 1) ? sAD : sTW) + r32 * 72 + hi * 8;
            f32x16 acc;
#pragma unroll
            for (int i = 0; i < 16; ++i) acc[i] = 0.f;
#pragma unroll
            for (int s = 0; s < 4; ++s) { const bf16x8 af = *(const bf16x8*)(ap + 16 * s); acc = __builtin_amdgcn_mfma_f32_32x32x16_bf16(af, wf[s], acc, 0, 0, 0); }
            float* dst = ((wid >> 1) ? sLA : sLW) + (wid & 1) * 32 + r32;
#pragma unroll
            for (int i = 0; i < 16; ++i) dst[crow(i, hi) * 65] = acc[i];
        }
        __syncthreads();
        float rkb;
        {
            float dec[4], av[4], kk[4], kp[4]; float ss = 0.f;
#pragma unroll
            for (int i = 0; i < 4; ++i) { const float lw = pw0[i] + sLW[tok * 65 + c0 + i]; dec[i] = __expf(-0.6065306597126334f * sgm(lw));
                av[i] = sgm(pa0[i] + sLA[tok * 65 + c0 + i]); kk[i] = k[i] * pkk[i]; ss += kk[i] * kk[i]; kp[i] = k[i] * (1.f + (av[i] - 1.f) * pka[i]); }
            ss = red16(ss); const float inv = 1.f / sqrtf(ss + 1e-12f);
            float br = 0.f, kr = 0.f, rk = 0.f; f32x4 o_w, o_n, o_b, o_k, o_rw, o_v;
#pragma unroll
            for (int i = 0; i < 4; ++i) { const float kn = kk[i] * inv, bb = kn * av[i]; o_w[i] = dec[i]; o_n[i] = -kn; o_b[i] = bb; o_k[i] = kp[i]; o_rw[i] = r[i] * dec[i]; o_v[i] = v[i];
                br += bb * r[i]; kr += kp[i] * r[i]; rk += r[i] * kp[i] * prk[i]; }
            br = red16(br); kr = red16(kr); rk = red16(rk); rkb = rk;
            *(f32x4*)(sW + tok * 64 + c0) = o_w; *(f32x4*)(sNKK + tok * 64 + c0) = o_n; *(f32x4*)(sB + tok * 64 + c0) = o_b; *(f32x4*)(sK + tok * 64 + c0) = o_k; *(f32x4*)(sRW + tok * 64 + c0) = o_rw; *(f32x4*)(sV + tok * 64 + c0) = o_v;
            if (cg == 0) { sSc[tok * 4 + 0] = br; sSc[tok * 4 + 1] = kr; }
        }
        __syncthreads();
#pragma unroll 2
        for (int tt = 0; tt < CT; ++tt) {
            const f32x4 n0 = *(const f32x4*)(sNKK + tt * 64 + 8 * jb), n1 = *(const f32x4*)(sNKK + tt * 64 + 8 * jb + 4);
            const f32x4 q0 = *(const f32x4*)(sRW + tt * 64 + 8 * jb), q1 = *(const f32x4*)(sRW + tt * 64 + 8 * jb + 4);
            const f32x4 w0 = *(const f32x4*)(sW + tt * 64 + 8 * jb), w1 = *(const f32x4*)(sW + tt * 64 + 8 * jb + 4);
            const f32x4 b0 = *(const f32x4*)(sB + tt * 64 + 8 * jb), b1 = *(const f32x4*)(sB + tt * 64 + 8 * jb + 4);
            const f32x4 k0 = *(const f32x4*)(sK + tt * 64 + 8 * jb), k1 = *(const f32x4*)(sK + tt * 64 + 8 * jb + 4);
            const float vi = sV[tt * 64 + si]; const float br = sSc[tt * 4 + 0], kr = sSc[tt * 4 + 1];
            float sa = (S[0] * n0[0] + S[1] * n0[1]) + (S[2] * n0[2] + S[3] * n0[3]) + (S[4] * n1[0] + S[5] * n1[1]) + (S[6] * n1[2] + S[7] * n1[3]);
            float yy = (S[0] * q0[0] + S[1] * q0[1]) + (S[2] * q0[2] + S[3] * q0[3]) + (S[4] * q1[0] + S[5] * q1[1]) + (S[6] * q1[2] + S[7] * q1[3]);
            sa = red8(sa); yy = red8(yy);
            const float y = yy + sa * br + vi * kr;
            S[0] = S[0] * w0[0] + sa * b0[0] + vi * k0[0]; S[1] = S[1] * w0[1] + sa * b0[1] + vi * k0[1]; S[2] = S[2] * w0[2] + sa * b0[2] + vi * k0[2]; S[3] = S[3] * w0[3] + sa * b0[3] + vi * k0[3];
            S[4] = S[4] * w1[0] + sa * b1[0] + vi * k1[0]; S[5] = S[5] * w1[1] + sa * b1[1] + vi * k1[1]; S[6] = S[6] * w1[2] + sa * b1[2] + vi * k1[2]; S[7] = S[7] * w1[3] + sa * b1[3] + vi * k1[3];
            if (jb == 0) sY[tt * 64 + si] = y;
        }
        __syncthreads();
        {
            const f32x4 y4 = *(const f32x4*)(sY + tok * 64 + c0);
            float mu = red16((y4[0] + y4[1]) + (y4[2] + y4[3])) * (1.f / 64.f);
            const float d0 = y4[0] - mu, d1 = y4[1] - mu, d2 = y4[2] - mu, d3 = y4[3] - mu;
            const float var = red16((d0 * d0 + d1 * d1) + (d2 * d2 + d3 * d3)) * (1.f / 64.f);
            const float rs = 1.f / sqrtf(var + 64e-5f);
            const float o0 = d0 * rs * pgg[0] + pgb[0] + rkb * v[0], o1 = d1 * rs * pgg[1] + pgb[1] + rkb * v[1], o2 = d2 * rs * pgg[2] + pgb[2] + rkb * v[2], o3 = d3 * rs * pgg[3] + pgb[3] + rkb * v[3];
            v2u w; w.x = pk2(o0, o1); w.y = pk2(o2, o3);
            *(v2u*)(YA + (rowbase + t) * DM + hc) = w;
        }
    }
}
}


#define LAS __attribute__((address_space(3)))
#define XB_TMO      128
#define XB_XCNT(j)  (256  + 64 * (j))
#define XB_XSUB(j)  (1280 + 64 * (j))
#define XB_XGEN(j)  (2304 + 64 * (j))
#define XB_TOP      3328
#define XB_TOPGEN   3392
#define XCD_BAR_WORDS 3456
#define XB_SPIN_CAP (1u << 18)

__device__ __forceinline__ unsigned xb_ld(unsigned* p)              { return __hip_atomic_load(p, __ATOMIC_RELAXED, __HIP_MEMORY_SCOPE_AGENT); }
__device__ __forceinline__ unsigned xb_add(unsigned* p, unsigned v) { return __hip_atomic_fetch_add(p, v, __ATOMIC_RELAXED, __HIP_MEMORY_SCOPE_AGENT); }
__device__ __forceinline__ unsigned xb_xcc_id() { return (unsigned)__builtin_amdgcn_s_getreg((3 << 11) | 20) & 0xFu; }
#define XB_SPIN(cond, bar) do { unsigned _sp = 0; while (cond) { __builtin_amdgcn_s_sleep(1); \
    if ((++_sp & 255u) == 0u) { if (xb_ld(&(bar)[XB_TMO])) break; if (_sp > XB_SPIN_CAP) { atomicAdd(&(bar)[XB_TMO], 1u); break; } } } } while (0)

struct XcdBarrier {
    unsigned* bar; unsigned x;
    volatile LAS unsigned* st;
};

__device__ __forceinline__ XcdBarrier xcd_barrier_post(unsigned* bar, volatile LAS unsigned* st) {
    XcdBarrier b; b.bar = bar; b.x = xb_xcc_id(); b.st = st;
    if (threadIdx.x == 0) (void)xb_add(&bar[XB_XCNT(b.x)], 1u);
    return b;
}
__device__ __forceinline__ void xcd_barrier_complete(unsigned* bar, unsigned x, unsigned& nloc, unsigned& nx) {
    const unsigned G = gridDim.x * gridDim.y * gridDim.z;
    unsigned sum, cnt, mine, sp = 0u;
    for (;;) {
        sum = 0u; cnt = 0u; mine = 0u;
#pragma unroll
        for (unsigned j = 0; j < 16; ++j) { const unsigned c = xb_ld(&bar[XB_XCNT(j)]); sum += c; cnt += (c > 0u) ? 1u : 0u; mine = (j == x) ? c : mine; }
        if (sum == G) break;
        __builtin_amdgcn_s_sleep(1);
        if ((++sp & 255u) == 0u) { if (xb_ld(&bar[XB_TMO])) break; if (sp > XB_SPIN_CAP) { atomicAdd(&bar[XB_TMO], 1u); break; } }
    }
    nloc = mine > 0u ? mine : 1u; nx = cnt > 0u ? cnt : 1u;
}

__device__ __forceinline__ void xcd_barrier(const XcdBarrier& b) {
    asm volatile("s_waitcnt vmcnt(0)" ::: "memory");
    __syncthreads();
    if (threadIdx.x == 0) {
        unsigned* bar = b.bar;
        __builtin_amdgcn_s_waitcnt(0);
        unsigned nloc = b.st[0], nx = b.st[1];
        if (nloc == 0u) { xcd_barrier_complete(bar, b.x, nloc, nx); b.st[0] = nloc; b.st[1] = nx; }
        const unsigned old = xb_add(&bar[XB_XSUB(b.x)], 1u);
        const unsigned gen = old / nloc;
        if (old + 1u == (gen + 1u) * nloc) {
            __builtin_amdgcn_fence(__ATOMIC_RELEASE, "agent");
            asm volatile("s_waitcnt vmcnt(0)" ::: "memory");
            const unsigned og = xb_add(&bar[XB_TOP], 1u);
            const unsigned tg = og / nx;
            if (og + 1u == (tg + 1u) * nx) xb_add(&bar[XB_TOPGEN], 1u);
            else XB_SPIN(xb_ld(&bar[XB_TOPGEN]) == tg, bar);
            __builtin_amdgcn_fence(__ATOMIC_ACQUIRE, "agent");
            xb_add(&bar[XB_XGEN(b.x)], 1u);
            asm volatile("s_waitcnt vmcnt(0)" ::: "memory");
        } else {
            XB_SPIN(xb_ld(&bar[XB_XGEN(b.x)]) == gen, bar);
            __builtin_amdgcn_fence(__ATOMIC_ACQUIRE, "agent");
            asm volatile("s_waitcnt vmcnt(0)" ::: "memory");
        }
    }
    __syncthreads();
}

constexpr int N_PHASES = 10;
template <bool COOP>
__global__ void __launch_bounds__(NWAVES * 64, 2) fwd_kernel(Args A) {
    extern __shared__ __attribute__((aligned(16))) unsigned char lds[];
    const int tid = threadIdx.x, lane = tid & 63; const int wave = __builtin_amdgcn_readfirstlane(tid >> 6);
    const int G = gridDim.x, bid = blockIdx.x;
    unsigned char* ws = A.ws;
    bf16* WIN_T = (bf16*)(ws + WS_WIN);
    bf16* Z = (bf16*)(ws + WS_Z); bf16* Vt = (bf16*)(ws + WS_VT);
    bf16* XN = (bf16*)((unsigned char*)A.out + DO_XN); bf16* YA = (bf16*)((unsigned char*)A.out + DO_YA);
    bf16* TM = XN;
    bf16* HP = YA;
    float* X1 = (float*)(ws + WS_X1); float* PE = (float*)(ws + WS_PE);
    PG8_LAS unsigned char* ldsg = (PG8_LAS unsigned char*)lds;
    const int lo = A.ph_lo, hi = A.ph_hi;
    if (COOP && A.pad == 0x7fffffff) cg::this_grid().sync();
    XcdBarrier bar; bar.bar = (unsigned*)(ws + WS_CTL) + CW_BAR; bar.x = 0; bar.st = nullptr;
    if (COOP) {
        volatile LAS unsigned* MISC = (volatile LAS unsigned*)((LAS unsigned char*)lds + MISC_OFF);
        if (tid < 32) MISC[tid] = 0u;
        __syncthreads();
        bar = xcd_barrier_post((unsigned*)(ws + WS_CTL) + CW_BAR, MISC + 8);
    }
#define IN(k) (lo <= (k) && (k) < hi)
#define SEAM(k) do { if (COOP && IN(k) && IN((k) + 1)) { xcd_barrier(bar); } } while (0)

    if (IN(0)) { p0_prologue(A, lds, G, bid); }
    SEAM(0);
    if (IN(1)) {
        pg8::Gemm g{XN, WIN_T, MTOK, N1, DM, DM}; pg8::StaticOrder S; S.init(MTOK, N1, G, bid);
        pg8::EpiZ1 E{Z, Vt, (const float*)(ws + WS_COS), (const float*)(ws + WS_SIN)};
        pg8::gemm_phase<pg8::EpiZ1, pg8::StaticOrder, true, true>(ldsg, g, S, E);
    }
    SEAM(1);
    if (IN(2)) {
        for (int hd = bid; hd < NB * 16; hd += G) rwkv::rwkv_head(lds, A, Z, YA, hd >> 4, hd & 15);
        __syncthreads();
        float lam;
        { const float* lv = A.diff_lam; const float s01 = wave_sum(lv[lane] * lv[64 + lane]), s23 = wave_sum(lv[128 + lane] * lv[192 + lane]); lam = __expf(s01) - __expf(s23) + LAMBDA_INIT; }
        unsigned* ctr = (unsigned*)(ws + WS_CTL) + CW_ATT;
        for (;;) {
            if (tid == 0) *(volatile unsigned*)(lds + att::OFF_Q) = atomicAdd(ctr, 1u);
            __syncthreads();
            const unsigned u = *(volatile unsigned*)(lds + att::OFF_Q);
            __syncthreads();
            if (u >= (unsigned)(NB * 8 * 16)) break;
            const int qb = 15 - (int)(u >> 6), bh = (int)(u & 63);
            att::attn_unit(lds, Z, Vt, Z, bh >> 3, bh & 7, qb, lam, A.subln_g);
        }
    }
    SEAM(2);
    if (IN(3)) {
        pg8::Gemm g{XN, WIN_T + (size_t)N1 * DM, MTOK, N2, DM, DM}; pg8::StaticOrder S; S.init(MTOK, N2, G, bid);
        pg8::EpiGates E{YA, Z};
        pg8::gemm_phase<pg8::EpiGates, pg8::StaticOrder, true, true>(ldsg, g, S, E);
    }
    SEAM(3);
    if (IN(4)) {
        pg8::Gemm g{YA, (const bf16*)(ws + WS_PA), MTOK, DM, DM, DM}; pg8::StaticOrder S; S.init(MTOK, DM, G, bid);
        pg8::EpiBranch<0> E{TM, Z, ZC_K};
        pg8::gemm_phase<pg8::EpiBranch<0>, pg8::StaticOrder, true, true>(ldsg, g, S, E);
    }
    SEAM(4);
    if (IN(5)) {
        pg8::Gemm g{Z + ZC_Q, (const bf16*)(ws + WS_PB), MTOK, DM, DM, ZP}; pg8::StaticOrder S; S.init(MTOK, DM, G, bid);
        pg8::EpiBranch<1> E{TM, Z, ZC_R};
        pg8::gemm_phase<pg8::EpiBranch<1>, pg8::StaticOrder, true, true>(ldsg, g, S, E);
    }
    SEAM(5);
    if (IN(6)) {
        { pg8::Gemm g{TM, (const bf16*)(ws + WS_WO), MTOK, DM, DM, DM}; pg8::StaticOrder S; S.init(MTOK, DM, G, bid);
          pg8::EpiF32<1> E{X1, A.x};
          pg8::gemm_phase<pg8::EpiF32<1>, pg8::StaticOrder, true, true>(ldsg, g, S, E); }
        { pg8::Gemm g{(const bf16*)(ws + WS_PBF), (const bf16*)(ws + WS_WPE), MTOK, DM, PLE, PLE}; pg8::StaticOrder S; S.init(MTOK, DM, G, bid);
          pg8::EpiF32<0> E{PE, nullptr};
          pg8::gemm_phase<pg8::EpiF32<0>, pg8::StaticOrder, true, true>(ldsg, g, S, E); }
    }
    SEAM(6);
    if (IN(7)) {
        const int gw = bid * NWAVES + wave, NGW = G * NWAVES;
        for (int m = gw; m < MTOK; m += NGW) rms_row_to_bf16(X1 + (size_t)m * DM, A.ple_norm_g, HP + (size_t)m * DM, lane);
    }
    SEAM(7);
    if (IN(8)) {
        pg8::Gemm g{HP, (const bf16*)(ws + WS_WPG), MTOK, DM, DM, DM}; pg8::StaticOrder S; S.init(MTOK, DM, G, bid);
        pg8::EpiF32<2> E{X1, PE};
        pg8::gemm_phase<pg8::EpiF32<2>, pg8::StaticOrder, true, true>(ldsg, g, S, E);
    }
    SEAM(8);
    if (IN(9)) {
        const int gw = bid * NWAVES + wave, NGW = G * NWAVES;
        for (int m = gw; m < MTOK; m += NGW) rms_row_to_f32(X1 + (size_t)m * DM, A.final_g, A.out + (size_t)m * DM, lane);
    }
#undef IN
#undef SEAM
}

#ifndef MK_N_LAUNCHES
#define MK_N_LAUNCHES 1
#endif
extern "C" void kernel_launch(void* const* d_in, const int* in_sizes, int n_in, void* d_out, int out_size, void* d_ws, size_t ws_size, hipStream_t stream) {
    static int grid = 0;
    if (grid == 0) {
        if (n_in != 23 || in_sizes[0] != MTOK * DM || out_size != MTOK * DM || ws_size < WS_END) { fprintf(stderr, "kernel_launch: unexpected shapes (n_in %d, in0 %d, out %d, ws %zu)\n", n_in, n_in > 0 ? in_sizes[0] : -1, out_size, ws_size); grid = -1; return; }
        int dev = 0, cus = 0;
        if (hipGetDevice(&dev) != hipSuccess || hipDeviceGetAttribute(&cus, hipDeviceAttributeMultiprocessorCount, dev) != hipSuccess) { grid = -1; return; }
        if (hipFuncSetAttribute((const void*)fwd_kernel<(MK_N_LAUNCHES == 1)>, hipFuncAttributeMaxDynamicSharedMemorySize, LDS_BYTES) != hipSuccess) { fprintf(stderr, "kernel_launch: hipFuncSetAttribute failed\n"); grid = -1; return; }
        int per_cu = 0;
        if (hipOccupancyMaxActiveBlocksPerMultiprocessor(&per_cu, (const void*)fwd_kernel<(MK_N_LAUNCHES == 1)>, NWAVES * 64, LDS_BYTES) != hipSuccess || per_cu < 1) { fprintf(stderr, "kernel_launch: occupancy query says %d\n", per_cu); }
        (void)hipGetLastError();
        grid = cus;
    }
    if (grid < 0) return;
    (void)hipMemsetAsync((char*)d_ws + WS_CTL, 0, CTL_ZERO_BYTES, stream);
    Args a{};
    a.x = (const float*)d_in[0]; a.p = (const float*)d_in[1]; a.pos = (const int*)d_in[2]; a.norm_g = (const float*)d_in[3]; a.w_in = (const float*)d_in[4];
    a.shift_mix = (const float*)d_in[5]; a.w0 = (const float*)d_in[6]; a.w_up = (const float*)d_in[7]; a.a0 = (const float*)d_in[8]; a.a_up = (const float*)d_in[9];
    a.k_k = (const float*)d_in[10]; a.k_a = (const float*)d_in[11]; a.r_k = (const float*)d_in[12]; a.gn_g = (const float*)d_in[13]; a.gn_b = (const float*)d_in[14];
    a.diff_lam = (const float*)d_in[15]; a.subln_g = (const float*)d_in[16]; a.w_branch = (const float*)d_in[17]; a.w_out = (const float*)d_in[18];
    a.ple_norm_g = (const float*)d_in[19]; a.w_pg = (const float*)d_in[20]; a.w_pe = (const float*)d_in[21]; a.final_g = (const float*)d_in[22];
    a.out = (float*)d_out; a.ws = (unsigned char*)d_ws; a.pad = 0;
#if MK_N_LAUNCHES == 1
    a.ph_lo = 0; a.ph_hi = N_PHASES; a.coop = 1;
    void* args[] = {&a};
    hipError_t e = hipLaunchCooperativeKernel((const void*)fwd_kernel<true>, dim3(grid), dim3(NWAVES * 64), args, LDS_BYTES, stream);
    if (e != hipSuccess) fprintf(stderr, "kernel_launch: cooperative launch failed: %s (grid %d)\n", hipGetErrorString(e), grid);
#else
    for (int ph = 0; ph < N_PHASES; ++ph) { a.ph_lo = ph; a.ph_hi = ph + 1; a.coop = 0;
        hipLaunchKernelGGL(fwd_kernel<false>, dim3(grid), dim3(NWAVES * 64), LDS_BYTES, stream, a); }
#endif
}
```

```cpp
#include <hip/hip_runtime.h>
#include <hip/hip_cooperative_groups.h>
#include <cstdio>
#include <cstdint>
namespace cg = cooperative_groups;

constexpr int NB = 8, SEQ = 2048, DM = 1024, MTOK = NB * SEQ;
constexpr int INC = 10368;
constexpr int PLE = 256;
constexpr int ZP = 5376;
constexpr int N1 = 6400;
constexpr int N2 = 4096;
constexpr int ZC_Q = 0, ZC_K = 1024, ZC_R = 2048, ZC_KA = 3072, ZC_VA = 4096, ZC_WD = 5120, ZC_AD = 5184;
constexpr float QSCALE = 0.125f * 1.4426950408889634f;
constexpr float LAMBDA_INIT = 0.2f;

namespace pg8 {
#define PG8_LAS __attribute__((address_space(3)))
typedef unsigned short bf16_t;
typedef short bf16x8 __attribute__((ext_vector_type(8)));
typedef float f32x4 __attribute__((ext_vector_type(4)));
typedef unsigned u32x4 __attribute__((ext_vector_type(4)));
constexpr int BM = 256, BK = 64, HALF = 128, HTB = HALF * BK * 2  , STAGE_BYTES = 8 * HTB, NXCD = 8, WGM = 8;

__host__ __device__ __forceinline__ int lds_byte(int r, int c) { const int st = (r >> 4) * 2 + (c >> 5), rr = r & 15, cc = c & 31, ob = rr * 64 + cc * 2; return st * 1024 + (ob ^ (((ob >> 9) & 1) << 5)); }
__host__ __device__ __forceinline__ void stage_rc(int b, int& R, int& C) { const int st = b / 1024, sb = b % 1024, swz = sb ^ (((sb >> 9) & 1) << 5); R = (st >> 1) * 16 + swz / 64; C = (st & 1) * 32 + (swz % 64) / 2; }
__host__ __device__ __forceinline__ int perm32(int rho) { const int n = rho >> 4, i = rho & 15; return 8 * (i >> 2) + 4 * n + (i & 3); }

struct Unit { int pm, pn; };
struct Gemm { const bf16_t* A; const bf16_t* Bt; int M, N, K, lda; };

struct StaticOrder {
    int nM, nN, nwg, G, c;
    __host__ __device__ void init(int M, int N, int G_, int c_) { nM = M / BM; nN = N / BM; nwg = nM * nN; G = G_; c = c_; }
    __host__ __device__ bool next(int i, Unit& u) const {
        const long L = (long)i * G + c; if (L >= nwg) return false;
        int wgid = (int)L; { const int q = nwg / NXCD, r = nwg % NXCD, xcd = wgid % NXCD, off = wgid / NXCD; wgid = (xcd < r ? xcd * (q + 1) : r * (q + 1) + (xcd - r) * q) + off; }
        const int nig = WGM * nN, gid = wgid / nig, fm = gid * WGM, gsz = (nM - fm) < WGM ? (nM - fm) : WGM;
        u.pm = fm + ((wgid % nig) % gsz); u.pn = (wgid % nig) / gsz; return true;
    }
    __device__ __forceinline__ void a_ready(const Unit&) const {}
    __device__ __forceinline__ void done(const Unit&) const {}
};

__device__ __forceinline__ unsigned cvt_pk_bf16(float lo, float hi) { unsigned r; asm volatile("v_cvt_pk_bf16_f32 %0, %1, %2" : "=v"(r) : "v"(lo), "v"(hi)); return r; }
typedef float f32x2 __attribute__((ext_vector_type(2)));
typedef unsigned u32x2 __attribute__((ext_vector_type(2)));
__device__ __forceinline__ float bf_lo(unsigned w) { return __uint_as_float(w << 16); }
__device__ __forceinline__ float bf_hi(unsigned w) { return __uint_as_float(w & 0xffff0000u); }
__device__ __forceinline__ float sigm(float v) { return 1.f / (1.f + __expf(-v)); }
__device__ __forceinline__ unsigned short f2bf1(float f) { unsigned u = __float_as_uint(f); return (unsigned short)((u + 0x7fffu + ((u >> 16) & 1u)) >> 16); }

struct EpiZ1 {
    static constexpr bool PERM = true, AFTER_DRAIN = false;
    bf16_t* Z; bf16_t* Vt; const float* cosT; const float* sinT;
    __device__ __forceinline__ void operator()(const f32x4 (&acc)[2][2][4][2], const Unit& u, int wr, int wc, int fr, int fq) const {
        const int pn = u.pn; const int row0 = u.pm * BM + wr * 64 + fr;
        if (pn >= 8 && pn < 12) {
            const int b = (u.pm * BM) / SEQ, t0 = (u.pm * BM) % SEQ + wr * 64 + fr;
#pragma unroll
            for (int ai = 0; ai < 2; ++ai)
#pragma unroll
                for (int m = 0; m < 4; ++m) { const int t = t0 + ai * HALF + m * 16;
#pragma unroll
                    for (int bj = 0; bj < 2; ++bj) { const int h = 2 * (pn - 8) + bj; bf16_t* vb = Vt + ((size_t)(b * 8 + h) * 128 + wc * 32 + 8 * fq) * SEQ + t;
#pragma unroll
                        for (int n = 0; n < 2; ++n)
#pragma unroll
                            for (int i = 0; i < 4; ++i) vb[(size_t)(4 * n + i) * SEQ] = f2bf1(acc[ai][bj][m][n][i]); } }
        } else {
            const int colbase = (pn < 8 ? pn : pn - 4) * BM + wc * 32 + 8 * fq;
            const bool rope = pn < 8; const float sc = pn < 4 ? QSCALE : 1.f; const int i0 = (wc & 1) * 16 + 4 * fq;
#pragma unroll
            for (int ai = 0; ai < 2; ++ai)
#pragma unroll
                for (int m = 0; m < 4; ++m) { const int row = row0 + ai * HALF + m * 16; bf16_t* rowp = Z + (size_t)row * ZP + colbase;
                    f32x4 c4 = {1.f, 1.f, 1.f, 1.f}, s4 = {0.f, 0.f, 0.f, 0.f};
                    if (rope) { c4 = *(const f32x4*)(cosT + (size_t)row * 32 + i0); s4 = *(const f32x4*)(sinT + (size_t)row * 32 + i0); }
#pragma unroll
                    for (int bj = 0; bj < 2; ++bj) { const f32x4 v0 = acc[ai][bj][m][0], v1 = acc[ai][bj][m][1];
                        f32x4 o0, o1;
                        o0[0] = v0[0] * c4[0] - v0[1] * s4[0]; o0[1] = v0[1] * c4[0] + v0[0] * s4[0];
                        o0[2] = v0[2] * c4[1] - v0[3] * s4[1]; o0[3] = v0[3] * c4[1] + v0[2] * s4[1];
                        o1[0] = v1[0] * c4[2] - v1[1] * s4[2]; o1[1] = v1[1] * c4[2] + v1[0] * s4[2];
                        o1[2] = v1[2] * c4[3] - v1[3] * s4[3]; o1[3] = v1[3] * c4[3] + v1[2] * s4[3];
                        o0 = o0 * sc; o1 = o1 * sc;
                        u32x4 w; w.x = cvt_pk_bf16(o0[0], o0[1]); w.y = cvt_pk_bf16(o0[2], o0[3]); w.z = cvt_pk_bf16(o1[0], o1[1]); w.w = cvt_pk_bf16(o1[2], o1[3]);
                        *(u32x4*)(rowp + bj * HALF) = w; } }
        }
    }
};

struct EpiGates {
    static constexpr bool PERM = true, AFTER_DRAIN = false;
    bf16_t* YA; bf16_t* Z;
    __device__ __forceinline__ void operator()(const f32x4 (&acc)[2][2][4][2], const Unit& u, int wr, int wc, int fr, int fq) const {
        const int pn = u.pn; const int row0 = u.pm * BM + wr * 64 + fr; const int cin = wc * 32 + 8 * fq;
        bf16_t* base; int pitch; const bool gate = pn < 8;
        if (pn < 4) { base = YA + pn * BM + cin; pitch = DM; }
        else { base = Z + (pn - 4) * BM + cin; pitch = ZP; }
#pragma unroll
        for (int ai = 0; ai < 2; ++ai)
#pragma unroll
            for (int m = 0; m < 4; ++m) { bf16_t* rowp = base + (size_t)(row0 + ai * HALF + m * 16) * pitch;
#pragma unroll
                for (int bj = 0; bj < 2; ++bj) { const f32x4 v0 = acc[ai][bj][m][0], v1 = acc[ai][bj][m][1];
                    float g[8] = {v0[0], v0[1], v0[2], v0[3], v1[0], v1[1], v1[2], v1[3]};
                    u32x4 w;
                    if (gate) { const u32x4 y = *(const u32x4*)(rowp + bj * HALF);
#pragma unroll
                        for (int i = 0; i < 8; ++i) g[i] = g[i] * sigm(g[i]);
                        w.x = cvt_pk_bf16(bf_lo(y.x) * g[0], bf_hi(y.x) * g[1]); w.y = cvt_pk_bf16(bf_lo(y.y) * g[2], bf_hi(y.y) * g[3]);
                        w.z = cvt_pk_bf16(bf_lo(y.z) * g[4], bf_hi(y.z) * g[5]); w.w = cvt_pk_bf16(bf_lo(y.w) * g[6], bf_hi(y.w) * g[7]);
                    } else {
#pragma unroll
                        for (int i = 0; i < 8; ++i) g[i] = sigm(g[i]);
                        w.x = cvt_pk_bf16(g[0], g[1]); w.y = cvt_pk_bf16(g[2], g[3]); w.z = cvt_pk_bf16(g[4], g[5]); w.w = cvt_pk_bf16(g[6], g[7]);
                    }
                    *(u32x4*)(rowp + bj * HALF) = w; } }
    }
};

template <int MODE> struct EpiBranch {
    static constexpr bool PERM = true, AFTER_DRAIN = false;
    bf16_t* T; const bf16_t* Z; int smcol;
    __device__ __forceinline__ void operator()(const f32x4 (&acc)[2][2][4][2], const Unit& u, int wr, int wc, int fr, int fq) const {
        const int row0 = u.pm * BM + wr * 64 + fr; const int col0 = u.pn * BM + wc * 32 + 8 * fq;
#pragma unroll
        for (int ai = 0; ai < 2; ++ai)
#pragma unroll
            for (int m = 0; m < 4; ++m) { const int row = row0 + ai * HALF + m * 16; bf16_t* tp = T + (size_t)row * DM + col0; const bf16_t* sp = Z + (size_t)row * ZP + smcol + col0;
#pragma unroll
                for (int bj = 0; bj < 2; ++bj) { const f32x4 v0 = acc[ai][bj][m][0], v1 = acc[ai][bj][m][1];
                    const u32x4 s = *(const u32x4*)(sp + bj * HALF);
                    float o[8] = {v0[0] * bf_lo(s.x), v0[1] * bf_hi(s.x), v0[2] * bf_lo(s.y), v0[3] * bf_hi(s.y), v1[0] * bf_lo(s.z), v1[1] * bf_hi(s.z), v1[2] * bf_lo(s.w), v1[3] * bf_hi(s.w)};
                    if (MODE == 1) { const u32x4 t = *(const u32x4*)(tp + bj * HALF);
                        o[0] += bf_lo(t.x); o[1] += bf_hi(t.x); o[2] += bf_lo(t.y); o[3] += bf_hi(t.y); o[4] += bf_lo(t.z); o[5] += bf_hi(t.z); o[6] += bf_lo(t.w); o[7] += bf_hi(t.w); }
                    u32x4 w; w.x = cvt_pk_bf16(o[0], o[1]); w.y = cvt_pk_bf16(o[2], o[3]); w.z = cvt_pk_bf16(o[4], o[5]); w.w = cvt_pk_bf16(o[6], o[7]);
                    *(u32x4*)(tp + bj * HALF) = w; } }
    }
};

template <int MODE> struct EpiF32 {
    static constexpr bool PERM = false, AFTER_DRAIN = false;
    float* C; const float* R;
    __device__ __forceinline__ void operator()(const f32x4 (&acc)[2][2][4][2], const Unit& u, int wr, int wc, int fr, int fq) const {
        const int row0 = u.pm * BM + wr * 64 + fr, col0 = u.pn * BM + wc * 32 + 4 * fq;
#pragma unroll
        for (int ai = 0; ai < 2; ++ai)
#pragma unroll
            for (int m = 0; m < 4; ++m) { const size_t off = (size_t)(row0 + ai * HALF + m * 16) * DM + col0;
#pragma unroll
                for (int bj = 0; bj < 2; ++bj)
#pragma unroll
                    for (int n = 0; n < 2; ++n) { const size_t o2 = off + bj * HALF + n * 16; f32x4 v = acc[ai][bj][m][n];
                        if (MODE == 1) v = v + *(const f32x4*)(R + o2);
                        if (MODE == 2) { const f32x4 r = *(const f32x4*)(R + o2), c = *(const f32x4*)(C + o2);
                            v[0] = c[0] + sigm(v[0]) * r[0]; v[1] = c[1] + sigm(v[1]) * r[1]; v[2] = c[2] + sigm(v[2]) * r[2]; v[3] = c[3] + sigm(v[3]) * r[3]; }
                        *(f32x4*)(C + o2) = v; } }
    }
};

template <class Epi, class Sched, bool ALIGN_EPI = false, bool SP2 = false>
__device__ __forceinline__ void gemm_phase(PG8_LAS unsigned char* lds, const Gemm g, const Sched& S, const Epi& E) {
    const int tid = threadIdx.x, wid = __builtin_amdgcn_readfirstlane(tid >> 6), lane = tid & 63, wr = wid >> 2, wc = wid & 3, fr = lane & 15, fq = lane >> 4;
    const int K = g.K, nt = K / BK;
    unsigned voffA[2], voffB[2];
#pragma unroll
    for (int i = 0; i < 2; ++i) { int R, C; stage_rc(tid * 16 + i * 8192, R, C); const int Rb = Epi::PERM ? ((R & ~31) + perm32(R & 31)) : R;
        voffA[i] = (unsigned)(R * g.lda + C) * 2u; voffB[i] = (unsigned)(Rb * K + C) * 2u; }
    const size_t kstep = (size_t)(BK * 2);
    const size_t hstepB = (size_t)HALF * K * 2, hstepA = (size_t)HALF * g.lda * 2;
    const size_t tstepA = 2 * hstepA, tstepB = 2 * hstepB;
    const unsigned ldsw = (unsigned)wid * 1024u;
    const int aoff = lds_byte(wr * 64 + fr, fq * 8), boff = lds_byte(wc * 32 + fr, fq * 8);
#define PG8_SA(b, h) (((b) * 2 + (h)) * HTB)
#define PG8_SB(b, h) ((4 + (b) * 2 + (h)) * HTB)
#define PG8_STAGE(bufoff, gbase, voff) do { _Pragma("unroll") for (int _i = 0; _i < 2; ++_i) \
        __builtin_amdgcn_global_load_lds((const unsigned*)((const char*)(gbase) + (voff)[_i]), (PG8_LAS unsigned*)(lds + (bufoff) + ldsw + _i * 8192), 16, 0, 0); } while (0)
#define PG8_LDA(dst, b, h) do { _Pragma("unroll") for (int m = 0; m < 4; ++m) _Pragma("unroll") for (int k = 0; k < 2; ++k) dst[m][k] = *(const PG8_LAS bf16x8*)(lds + PG8_SA(b, h) + aoff + m * 2048 + k * 1024); } while (0)
#define PG8_LDB(dst, b, h) do { _Pragma("unroll") for (int n = 0; n < 2; ++n) _Pragma("unroll") for (int k = 0; k < 2; ++k) dst[n][k] = *(const PG8_LAS bf16x8*)(lds + PG8_SB(b, h) + boff + n * 2048 + k * 1024); } while (0)
#define PG8_MMA(ai, bj, At, Bt) do { __builtin_amdgcn_s_setprio(1); _Pragma("unroll") for (int m = 0; m < 4; ++m) _Pragma("unroll") for (int n = 0; n < 2; ++n) _Pragma("unroll") for (int k = 0; k < 2; ++k) \
        acc[ai][bj][m][n] = __builtin_amdgcn_mfma_f32_16x16x32_bf16(Bt[n][k], At[m][k], acc[ai][bj][m][n], 0, 0, 0); __builtin_amdgcn_s_setprio(0); } while (0)
#define PG8_WAIT_V(n) asm volatile("s_waitcnt vmcnt(" #n ")" ::: "memory")
#define PG8_WAIT_L(n) asm volatile("s_waitcnt lgkmcnt(" #n ")" ::: "memory")
#define PG8_BAR __builtin_amdgcn_s_barrier()
#define PG8_SCHED __builtin_amdgcn_sched_barrier(0)
    Unit cur, nxt; int ui = 0;
    if (!S.next(0, cur)) return;
    f32x4 acc[2][2][4][2];
#pragma unroll
    for (int a = 0; a < 2; ++a)
#pragma unroll
        for (int b = 0; b < 2; ++b)
#pragma unroll
            for (int m = 0; m < 4; ++m)
#pragma unroll
                for (int n = 0; n < 2; ++n) acc[a][b][m][n] = (f32x4){0.f, 0.f, 0.f, 0.f};
    bf16x8 At[4][2], B0[2][2], B1[2][2];
    const char* cA = (const char*)g.A + (size_t)cur.pm * tstepA; const char* cB = (const char*)g.Bt + (size_t)cur.pn * tstepB;
    S.a_ready(cur);
    if constexpr (SP2) {
        PG8_STAGE(PG8_SB(0, 0), cB, voffB); PG8_STAGE(PG8_SB(0, 1), cB + hstepB, voffB); PG8_STAGE(PG8_SA(0, 0), cA, voffA); PG8_STAGE(PG8_SA(0, 1), cA + hstepA, voffA);
        if (wr == 1) PG8_BAR;
        PG8_WAIT_V(2); PG8_BAR;
        PG8_STAGE(PG8_SB(1, 0), cB + kstep, voffB); PG8_STAGE(PG8_SA(1, 0), cA + kstep, voffA); PG8_STAGE(PG8_SB(1, 1), cB + hstepB + kstep, voffB);
        PG8_WAIT_V(6); PG8_BAR;
    } else {
        PG8_STAGE(PG8_SB(0, 0), cB, voffB); PG8_STAGE(PG8_SA(0, 0), cA, voffA); PG8_STAGE(PG8_SB(0, 1), cB + hstepB, voffB); PG8_STAGE(PG8_SA(0, 1), cA + hstepA, voffA);
        if (wr == 1) PG8_BAR;
        PG8_WAIT_V(4); PG8_BAR;
        PG8_STAGE(PG8_SB(1, 0), cB + kstep, voffB); PG8_STAGE(PG8_SA(1, 0), cA + kstep, voffA); PG8_STAGE(PG8_SB(1, 1), cB + hstepB + kstep, voffB);
        PG8_WAIT_V(6); PG8_BAR;
    }
    for (;;) {
        const bool has_next = S.next(ui + 1, nxt);
        const char* nA = has_next ? (const char*)g.A + (size_t)nxt.pm * tstepA : cA; const char* nB = has_next ? (const char*)g.Bt + (size_t)nxt.pn * tstepB : cB;
        for (int t = 0; t < nt; t += 2) {
            const bool last = (t == nt - 2);
            const char* a1 = cA + (size_t)(t + 1) * kstep;
            const char* a2 = last ? nA : cA + (size_t)(t + 2) * kstep; const char* b2 = last ? nB : cB + (size_t)(t + 2) * kstep;
            const char* a3 = a2 + kstep; const char* b3 = b2 + kstep;
            if (last && has_next) S.a_ready(nxt);
            if constexpr (SP2) {
            PG8_LDB(B0, 0, 0); PG8_LDB(B1, 0, 1); PG8_SCHED; PG8_LDA(At, 0, 0); PG8_STAGE(PG8_SA(1, 1), a1 + hstepA, voffA);
            PG8_WAIT_V(8); PG8_WAIT_L(0); PG8_BAR; PG8_MMA(0, 0, At, B0); PG8_MMA(0, 1, At, B1); PG8_BAR; PG8_SCHED;
            PG8_LDA(At, 0, 1); PG8_STAGE(PG8_SB(0, 0), b2, voffB); PG8_STAGE(PG8_SB(0, 1), b2 + hstepB, voffB); PG8_STAGE(PG8_SA(0, 0), a2, voffA);
            PG8_WAIT_V(8); PG8_WAIT_L(0); PG8_BAR; PG8_MMA(1, 0, At, B0); PG8_MMA(1, 1, At, B1); PG8_BAR; PG8_SCHED;
            PG8_LDB(B0, 1, 0); PG8_LDB(B1, 1, 1); PG8_SCHED; PG8_LDA(At, 1, 0); PG8_STAGE(PG8_SA(0, 1), a2 + hstepA, voffA);
            PG8_WAIT_V(8); PG8_WAIT_L(0); PG8_BAR; PG8_MMA(0, 0, At, B0); PG8_MMA(0, 1, At, B1); PG8_BAR; PG8_SCHED;
            PG8_LDA(At, 1, 1); PG8_STAGE(PG8_SB(1, 0), b3, voffB); PG8_STAGE(PG8_SB(1, 1), b3 + hstepB, voffB); PG8_STAGE(PG8_SA(1, 0), a3, voffA);
            PG8_WAIT_V(8); PG8_WAIT_L(0); PG8_BAR; PG8_MMA(1, 0, At, B0); PG8_MMA(1, 1, At, B1); PG8_BAR; PG8_SCHED;
            } else {
            PG8_LDB(B0, 0, 0); PG8_SCHED; PG8_LDA(At, 0, 0); PG8_STAGE(PG8_SA(1, 1), a1 + hstepA, voffA);
            PG8_WAIT_L(8); PG8_BAR; PG8_WAIT_L(0); PG8_MMA(0, 0, At, B0); PG8_BAR; PG8_SCHED;
            PG8_LDB(B1, 0, 1); PG8_STAGE(PG8_SB(0, 0), b2, voffB);
            PG8_BAR; PG8_WAIT_L(0); PG8_MMA(0, 1, At, B1); PG8_BAR;
            PG8_LDA(At, 0, 1); PG8_STAGE(PG8_SA(0, 0), a2, voffA);
            PG8_BAR; PG8_WAIT_L(0); PG8_MMA(1, 0, At, B0); PG8_BAR; PG8_SCHED;
            PG8_STAGE(PG8_SB(0, 1), b2 + hstepB, voffB);
            PG8_WAIT_V(6); PG8_BAR; PG8_MMA(1, 1, At, B1); PG8_BAR;
            PG8_LDB(B0, 1, 0); PG8_SCHED; PG8_LDA(At, 1, 0); PG8_STAGE(PG8_SA(0, 1), a2 + hstepA, voffA);
            PG8_WAIT_L(8); PG8_BAR; PG8_WAIT_L(0); PG8_MMA(0, 0, At, B0); PG8_BAR; PG8_SCHED;
            PG8_LDB(B1, 1, 1); PG8_STAGE(PG8_SB(1, 0), b3, voffB);
            PG8_BAR; PG8_WAIT_L(0); PG8_MMA(0, 1, At, B1); PG8_BAR;
            PG8_LDA(At, 1, 1); PG8_STAGE(PG8_SA(1, 0), a3, voffA);
            PG8_BAR; PG8_WAIT_L(0); PG8_MMA(1, 0, At, B0); PG8_BAR; PG8_SCHED;
            PG8_STAGE(PG8_SB(1, 1), b3 + hstepB, voffB);
            PG8_WAIT_V(6); PG8_BAR; PG8_MMA(1, 1, At, B1); PG8_BAR;
            }
        }
        if constexpr (ALIGN_EPI) { if (wr == 0) PG8_BAR; }
        if constexpr (!Epi::AFTER_DRAIN) { E(acc, cur, wr, wc, fr, fq); S.done(cur); }
        if (!has_next) break;
#pragma unroll
        for (int a = 0; a < 2; ++a)
#pragma unroll
            for (int b = 0; b < 2; ++b)
#pragma unroll
                for (int m = 0; m < 4; ++m)
#pragma unroll
                    for (int n = 0; n < 2; ++n) acc[a][b][m][n] = (f32x4){0.f, 0.f, 0.f, 0.f};
        cur = nxt; cA = nA; cB = nB; ++ui;
        if constexpr (ALIGN_EPI) { if (wr == 1) PG8_BAR; }
    }
    PG8_WAIT_V(0);
    if constexpr (!ALIGN_EPI) { if (wr == 0) PG8_BAR; }
    PG8_BAR;
    if constexpr (Epi::AFTER_DRAIN) { E.fused(acc, cur, wr, wc, fr, fq, lds, wid, lane); S.done(cur); }
#undef PG8_SA
#undef PG8_SB
#undef PG8_STAGE
#undef PG8_LDA
#undef PG8_LDB
#undef PG8_MMA
#undef PG8_WAIT_V
#undef PG8_WAIT_L
#undef PG8_BAR
#undef PG8_SCHED
}
}

constexpr size_t MiB = 1u << 20;
constexpr size_t WS_CTL = 0, CTL_ZERO_BYTES = 65536;
constexpr size_t WS_WIN = 1 * MiB;
constexpr size_t WS_PA = 22 * MiB, WS_PB = 24 * MiB, WS_WO = 26 * MiB, WS_WPG = 28 * MiB, WS_WPE = 30 * MiB;
constexpr size_t WS_WUP = 30 * MiB + 512 * 1024, WS_AUP = WS_WUP + 128 * 1024;
constexpr size_t WS_COS = 31 * MiB, WS_SIN = 33 * MiB;
constexpr size_t WS_PBF = 35 * MiB;
constexpr size_t WS_Z = 44 * MiB;
constexpr size_t WS_VT = 212 * MiB;
constexpr size_t WS_END = 244 * MiB;
constexpr size_t WS_X1 = WS_Z, WS_PE = WS_Z + 64 * MiB;
static_assert(WS_Z + (size_t)MTOK * ZP * 2 <= WS_VT && WS_VT + (size_t)MTOK * DM * 2 <= WS_END && WS_END <= 256 * MiB, "ws map");
constexpr size_t DO_XN = 0, DO_YA = 32 * MiB;
constexpr int CW_ATT = 64;
constexpr int CW_BAR = 4096;
constexpr int MISC_OFF = 147456 - 128;

constexpr int NWAVES = 8;
constexpr int LDS_BYTES = 147456;

typedef unsigned short bf16;
typedef unsigned v4u __attribute__((ext_vector_type(4)));
typedef unsigned v2u __attribute__((ext_vector_type(2)));
typedef float f32x4 __attribute__((ext_vector_type(4)));
typedef float f32x16 __attribute__((ext_vector_type(16)));
typedef short bf16x8 __attribute__((ext_vector_type(8)));
typedef short s16x4 __attribute__((ext_vector_type(4)));
#define LDS_WAIT() asm volatile("s_waitcnt lgkmcnt(0)" ::: "memory")

__device__ __forceinline__ unsigned f2bf(float f) { unsigned u = __float_as_uint(f); return (u + 0x7fffu + ((u >> 16) & 1u)) >> 16; }
__device__ __forceinline__ unsigned pk2(float lo, float hi) { return f2bf(lo) | (f2bf(hi) << 16); }
__device__ __forceinline__ float bflo(unsigned w) { return __uint_as_float(w << 16); }
__device__ __forceinline__ float bfhi(unsigned w) { return __uint_as_float(w & 0xffff0000u); }
__device__ __forceinline__ float wave_sum(float v) {
#pragma unroll
    for (int o = 1; o < 64; o <<= 1) v += __shfl_xor(v, o);
    return v;
}
template <int CTRL> __device__ __forceinline__ float dppf(float x) { return __builtin_bit_cast(float, __builtin_amdgcn_update_dpp(0, __builtin_bit_cast(int, x), CTRL, 0xf, 0xf, true)); }
__device__ __forceinline__ float red8(float x) { x += dppf<0xB1>(x); x += dppf<0x4E>(x); x += dppf<0x141>(x); return x; }
__device__ __forceinline__ float red16(float x) { x = red8(x); x += dppf<0x140>(x); return x; }
__device__ __forceinline__ int crow(int r, int hi) { return (r & 3) + 8 * (r >> 2) + 4 * hi; }

struct Args {
    const float *x, *p; const int* pos; const float *norm_g, *w_in, *shift_mix, *w0, *w_up, *a0, *a_up, *k_k, *k_a, *r_k, *gn_g, *gn_b, *diff_lam, *subln_g, *w_branch, *w_out, *ple_norm_g, *w_pg, *w_pe, *final_g;
    float* out; unsigned char* ws; int ph_lo, ph_hi, coop, pad;
};

__device__ __forceinline__ int win_row(int n) {
    if (n < 3072) return 3072 + n;
    if (n < 3200) return 6144 + (n - 3072);
    if (n < 5248) { const int j = n - 3200; return (j & ~63) + 2 * (j & 31) + ((j >> 5) & 1); }
    if (n < 6272) return 2048 + (n - 5248);
    return N1 + (n - 6272);
}
template <bool WIN> __device__ __forceinline__ void p0_transpose_item(const float* W, int Nsrc, int K, bf16* WT, __attribute__((address_space(3))) float* scr, int kb, int nb, int lane) {
    const int k0 = 64 * kb, n0 = 32 * nb;
#pragma unroll 8
    for (int i = 0; i < 32; ++i) { const int kk = 2 * i + (lane >> 5); scr[kk * 33 + (lane & 31)] = W[(size_t)(k0 + kk) * Nsrc + n0 + (lane & 31)]; }
    LDS_WAIT(); asm volatile("" ::: "memory");
    const int c = lane & 7;
#pragma unroll
    for (int j = 0; j < 4; ++j) { const int n = (lane >> 3) + 8 * j; const __attribute__((address_space(3))) float* s = scr + (8 * c) * 33 + n;
        v4u o; o.x = pk2(s[0 * 33], s[1 * 33]); o.y = pk2(s[2 * 33], s[3 * 33]); o.z = pk2(s[4 * 33], s[5 * 33]); o.w = pk2(s[6 * 33], s[7 * 33]);
        const int drow = WIN ? win_row(n0 + n) : (n0 + n);
        *(v4u*)(WT + (size_t)drow * K + k0 + 8 * c) = o; }
    LDS_WAIT(); asm volatile("" ::: "memory");
}
__device__ __forceinline__ void rms_row_to_bf16(const float* xrow, const float* g, bf16* orow, int lane) {
    const f32x4* xr = (const f32x4*)xrow + lane; const f32x4* gr = (const f32x4*)g + lane;
    f32x4 v[4]; float s = 0.f;
#pragma unroll
    for (int j = 0; j < 4; ++j) { v[j] = xr[64 * j]; s += (v[j].x * v[j].x + v[j].y * v[j].y) + (v[j].z * v[j].z + v[j].w * v[j].w); }
    const float rstd = 1.f / sqrtf(wave_sum(s) * (1.f / DM) + 1e-6f);
    unsigned long long* o8 = (unsigned long long*)orow + lane;
#pragma unroll
    for (int j = 0; j < 4; ++j) { const f32x4 gg = gr[64 * j]; o8[64 * j] = (unsigned long long)pk2(v[j].x * rstd * gg.x, v[j].y * rstd * gg.y) | ((unsigned long long)pk2(v[j].z * rstd * gg.z, v[j].w * rstd * gg.w) << 32); }
}
__device__ __forceinline__ void rms_row_to_f32(const float* xrow, const float* g, float* orow, int lane) {
    const f32x4* xr = (const f32x4*)xrow + lane; const f32x4* gr = (const f32x4*)g + lane;
    f32x4 v[4]; float s = 0.f;
#pragma unroll
    for (int j = 0; j < 4; ++j) { v[j] = xr[64 * j]; s += (v[j].x * v[j].x + v[j].y * v[j].y) + (v[j].z * v[j].z + v[j].w * v[j].w); }
    const float rstd = 1.f / sqrtf(wave_sum(s) * (1.f / DM) + 1e-6f);
    f32x4* o = (f32x4*)orow + lane;
#pragma unroll
    for (int j = 0; j < 4; ++j) { const f32x4 gg = gr[64 * j]; o[64 * j] = v[j] * rstd * gg; }
}

__device__ __forceinline__ void p0_prologue(const Args& A, unsigned char* ldsraw, int G, int bid) {
    const int tid = threadIdx.x, lane = tid & 63, wave = __builtin_amdgcn_readfirstlane(tid >> 6);
    __attribute__((address_space(3))) float* scr = (__attribute__((address_space(3))) float*)((__attribute__((address_space(3))) unsigned char*)ldsraw + wave * 16384);
    const int gw = bid * NWAVES + wave, NGW = G * NWAVES;
    unsigned char* ws = A.ws;
    bf16* WIN_T = (bf16*)(ws + WS_WIN);
    constexpr int I_IN = 16 * 324, I_SQ = 16 * 32, I_PE = 4 * 32, I_LR = 32;
    constexpr int NITEMS = I_IN + 4 * I_SQ + I_PE + 2 * I_LR;
    for (int it = gw; it < NITEMS; it += NGW) {
        int r = it;
        if (r < I_IN) { p0_transpose_item<true>(A.w_in, INC, DM, WIN_T, scr, r / 324, r % 324, lane); continue; } r -= I_IN;
        if (r < I_SQ) { p0_transpose_item<false>(A.w_branch, DM, DM, (bf16*)(ws + WS_PA), scr, r / 32, r % 32, lane); continue; } r -= I_SQ;
        if (r < I_SQ) { p0_transpose_item<false>(A.w_branch + (size_t)DM * DM, DM, DM, (bf16*)(ws + WS_PB), scr, r / 32, r % 32, lane); continue; } r -= I_SQ;
        if (r < I_SQ) { p0_transpose_item<false>(A.w_out, DM, DM, (bf16*)(ws + WS_WO), scr, r / 32, r % 32, lane); continue; } r -= I_SQ;
        if (r < I_SQ) { p0_transpose_item<false>(A.w_pg, DM, DM, (bf16*)(ws + WS_WPG), scr, r / 32, r % 32, lane); continue; } r -= I_SQ;
        if (r < I_PE) { p0_transpose_item<false>(A.w_pe, DM, PLE, (bf16*)(ws + WS_WPE), scr, r / 32, r % 32, lane); continue; } r -= I_PE;
        if (r < I_LR) { p0_transpose_item<false>(A.w_up, DM, 64, (bf16*)(ws + WS_WUP), scr, 0, r, lane); continue; } r -= I_LR;
        p0_transpose_item<false>(A.a_up, DM, 64, (bf16*)(ws + WS_AUP), scr, 0, r, lane);
    }
    { const int gt = bid * (NWAVES * 64) + tid, NT = G * NWAVES * 64; v4u z = {0u, 0u, 0u, 0u};
      for (int i = gt; i < 128 * 128; i += NT) *((v4u*)(WIN_T + (size_t)6272 * DM) + i) = z; }
    bf16* XN = (bf16*)((unsigned char*)A.out + DO_XN);
    for (int m = gw; m < MTOK; m += NGW) rms_row_to_bf16(A.x + (size_t)m * DM, A.norm_g, XN + (size_t)m * DM, lane);
    { const int gt = bid * (NWAVES * 64) + tid, NT = G * NWAVES * 64; v2u* o = (v2u*)(ws + WS_PBF); const f32x4* pi = (const f32x4*)A.p;
      for (int i = gt; i < MTOK * PLE / 4; i += NT) { const f32x4 v = pi[i]; v2u w; w.x = pk2(v.x, v.y); w.y = pk2(v.z, v.w); o[i] = w; } }
    { const int gt = bid * (NWAVES * 64) + tid, NT = G * NWAVES * 64; float* ct = (float*)(ws + WS_COS); float* st = (float*)(ws + WS_SIN);
      for (int i = gt; i < MTOK * 32; i += NT) { const int tok = i >> 5, f = i & 31; double invd = 1.0; for (int k = 0; k < f; ++k) invd *= 0.7498942093324559;
          const float inv = (float)invd; const float ang = (float)A.pos[tok] * inv;
          const double rev = (double)ang * 0.15915494309189535; const float fr = (float)(rev - __builtin_rint(rev));
          ct[i] = __builtin_amdgcn_cosf(fr); st[i] = __builtin_amdgcn_sinf(fr); } }
}

namespace att {
typedef float f32x2a __attribute__((ext_vector_type(2))); typedef __bf16 bf16x2a __attribute__((ext_vector_type(2)));
__device__ __forceinline__ unsigned cvtpk2(float lo, float hi) { f32x2a v = {lo, hi}; bf16x2a b = __builtin_convertvector(v, bf16x2a); return __builtin_bit_cast(unsigned, b); }
constexpr int KPB = 144;
constexpr int KBUF = 2 * 64 * KPB;
constexpr int VBUF = 128 * KPB;
constexpr int OFF_V = 2 * KBUF;
constexpr int OFF_WS = OFF_V + 2 * VBUF;
constexpr int OFF_Q = OFF_WS + 2048;
__device__ __forceinline__ void attn_unit(unsigned char* lds, const bf16* Z, const bf16* Vt, bf16* YB, int b, int h, int qb, float lam, const float* subln_g) {
    const int tid = threadIdx.x, lane = tid & 63, r32 = lane & 31, hi = lane >> 5; const int wid = __builtin_amdgcn_readfirstlane(tid >> 6);
    const int c = wid >> 2, wq = wid & 3;
    const int q0 = qb * 128, rq0 = q0 + wq * 32, nT = 2 * qb + 2;
    const size_t rowbase = (size_t)b * SEQ;
    float* wscr = (float*)(lds + OFF_WS) + wid * 64;
    bf16x8 qf[4];
    { const bf16* qp = Z + (rowbase + rq0 + r32) * ZP + ZC_Q + h * 128 + c * 64 + hi * 8;
#pragma unroll
      for (int s = 0; s < 4; ++s) qf[s] = *(const bf16x8*)(qp + 16 * s); }
    const int krow = (tid >> 3) & 63, kch = tid & 7;
    const bf16* ksrc = Z + (rowbase + krow) * ZP + ZC_K + h * 128 + kch * 8;
    const int vdv = tid >> 3, vch = tid & 7;
    const bf16* vsrc = Vt + ((size_t)(b * 8 + h) * 128 + vdv) * SEQ + vch * 8;
    v4u kr[2], vr[2];
#define ATT_GLOAD(t) do { const size_t ko = (size_t)(t) * 64 * ZP; kr[0] = *(const v4u*)(ksrc + ko); kr[1] = *(const v4u*)(ksrc + ko + 64); \
        vr[0] = *(const v4u*)(vsrc + (t) * 64); vr[1] = *(const v4u*)(vsrc + (size_t)64 * SEQ + (t) * 64); } while (0)
#define ATT_LSTORE(buf) do { *(v4u*)(lds + (buf) * KBUF + krow * KPB + kch * 16) = kr[0]; *(v4u*)(lds + (buf) * KBUF + 64 * KPB + krow * KPB + kch * 16) = kr[1]; \
        *(v4u*)(lds + OFF_V + (buf) * VBUF + vdv * KPB + vch * 16) = vr[0]; *(v4u*)(lds + OFF_V + (buf) * VBUF + (vdv + 64) * KPB + vch * 16) = vr[1]; } while (0)
    f32x16 o[4];
#pragma unroll
    for (int d = 0; d < 4; ++d)
#pragma unroll
        for (int r = 0; r < 16; ++r) o[d][r] = 0.f;
    float m_run = -INFINITY, l_run = 0.f;
    ATT_GLOAD(0); ATT_LSTORE(0); __syncthreads();
    for (int t = 0; t < nT; ++t) {
        const int buf = t & 1;
        if (t + 1 < nT) ATT_GLOAD(t + 1);
        const int kv0 = 64 * t;
        if (kv0 <= rq0 + 31) {
            f32x16 p0, p1;
#pragma unroll
            for (int r = 0; r < 16; ++r) { p0[r] = 0.f; p1[r] = 0.f; }
            const unsigned char* kb = lds + buf * KBUF + c * (64 * KPB) + r32 * KPB + hi * 16;
#pragma unroll
            for (int s = 0; s < 4; ++s) { const bf16x8 k0f = *(const bf16x8*)(kb + s * 32), k1f = *(const bf16x8*)(kb + 32 * KPB + s * 32);
                p0 = __builtin_amdgcn_mfma_f32_32x32x16_bf16(k0f, qf[s], p0, 0, 0, 0); p1 = __builtin_amdgcn_mfma_f32_32x32x16_bf16(k1f, qf[s], p1, 0, 0, 0); }
            if (kv0 + 63 > rq0) { const int q = rq0 + r32;
#pragma unroll
                for (int r = 0; r < 16; ++r) { const int kv = kv0 + crow(r, hi); if (kv > q) p0[r] = -INFINITY; if (kv + 32 > q) p1[r] = -INFINITY; } }
            float mx = fmaxf(p0[0], p1[0]);
#pragma unroll
            for (int r = 1; r < 16; ++r) mx = fmaxf(mx, fmaxf(p0[r], p1[r]));
            mx = fmaxf(mx, __shfl_xor(mx, 32));
            if (__any(mx > m_run + 8.f)) {
                const float m_new = fmaxf(m_run, mx); const float alpha = __builtin_amdgcn_exp2f(m_run - m_new); m_run = m_new;
                l_run *= alpha;
                asm volatile("" ::: "memory");
                if (hi == 0) wscr[r32] = alpha;
                LDS_WAIT();
#pragma unroll
                for (int r = 0; r < 16; ++r) { const float a = wscr[crow(r, hi)];
#pragma unroll
                    for (int d = 0; d < 4; ++d) o[d][r] *= a; }
                asm volatile("" ::: "memory");
            }
            float ls = 0.f;
#pragma unroll
            for (int r = 0; r < 16; ++r) { p0[r] = __builtin_amdgcn_exp2f(p0[r] - m_run); p1[r] = __builtin_amdgcn_exp2f(p1[r] - m_run); ls += p0[r] + p1[r]; }
            l_run += ls;
            bf16x8 pa[4];
#pragma unroll
            for (int s = 0; s < 2; ++s) { v4u w0, w1;
                w0.x = cvtpk2(p0[8 * s + 0], p0[8 * s + 1]); w0.y = cvtpk2(p0[8 * s + 2], p0[8 * s + 3]); w0.z = cvtpk2(p0[8 * s + 4], p0[8 * s + 5]); w0.w = cvtpk2(p0[8 * s + 6], p0[8 * s + 7]);
                w1.x = cvtpk2(p1[8 * s + 0], p1[8 * s + 1]); w1.y = cvtpk2(p1[8 * s + 2], p1[8 * s + 3]); w1.z = cvtpk2(p1[8 * s + 4], p1[8 * s + 5]); w1.w = cvtpk2(p1[8 * s + 6], p1[8 * s + 7]);
                pa[s] = __builtin_bit_cast(bf16x8, w0); pa[2 + s] = __builtin_bit_cast(bf16x8, w1); }
            const unsigned char* vb = lds + OFF_V + buf * VBUF + r32 * KPB + hi * 8;
#pragma unroll
            for (int d = 0; d < 4; ++d)
#pragma unroll
                for (int s = 0; s < 4; ++s) { const s16x4 lo = *(const s16x4*)(vb + d * 32 * KPB + s * 32), h4 = *(const s16x4*)(vb + d * 32 * KPB + s * 32 + 16);
                    const bf16x8 vf = {lo[0], lo[1], lo[2], lo[3], h4[0], h4[1], h4[2], h4[3]};
                    o[d] = __builtin_amdgcn_mfma_f32_32x32x16_bf16(pa[s], vf, o[d], 0, 0, 0); }
        }
        if (t + 1 < nT) ATT_LSTORE(buf ^ 1);
        __syncthreads();
    }
#undef ATT_GLOAD
#undef ATT_LSTORE
    { const float lt = l_run + __shfl_xor(l_run, 32);
      asm volatile("" ::: "memory");
      if (hi == 0) wscr[r32] = 1.f / lt;
      LDS_WAIT();
#pragma unroll
      for (int r = 0; r < 16; ++r) { const float a = wscr[crow(r, hi)];
#pragma unroll
          for (int d = 0; d < 4; ++d) o[d][r] *= a; }
      asm volatile("" ::: "memory"); }
    float* comb = (float*)lds + wq * (32 * 128);
    if (c == 1) {
#pragma unroll
        for (int r = 0; r < 16; ++r)
#pragma unroll
            for (int d = 0; d < 4; ++d) comb[crow(r, hi) * 128 + 32 * d + r32] = o[d][r];
    }
    __syncthreads();
    if (c == 0) {
        float g[4];
#pragma unroll
        for (int d = 0; d < 4; ++d) g[d] = subln_g[32 * d + r32] * (1.f - LAMBDA_INIT);
#pragma unroll
        for (int r = 0; r < 16; ++r) { const int qr = crow(r, hi); float dv[4]; float ss = 0.f;
#pragma unroll
            for (int d = 0; d < 4; ++d) { dv[d] = o[d][r] - lam * comb[qr * 128 + 32 * d + r32]; ss += dv[d] * dv[d]; }
            ss += __shfl_xor(ss, 1); ss += __shfl_xor(ss, 2); ss += __shfl_xor(ss, 4); ss += __shfl_xor(ss, 8); ss += __shfl_xor(ss, 16);
            const float rs = 1.f / sqrtf(ss * (1.f / 128.f) + 1e-5f);
            bf16* yp = YB + (rowbase + rq0 + qr) * ZP + ZC_Q + h * 128 + r32;
#pragma unroll
            for (int d = 0; d < 4; ++d) yp[32 * d] = (bf16)f2bf(dv[d] * rs * g[d]); }
    }
    __syncthreads();
}
}

namespace rwkv {
constexpr int SC = 64;
constexpr int PB = 144;
constexpr int OFF_TW = 0, OFF_AD = 9216, OFF_LW = 18432, OFF_LA = 35072, OFF_LG = 51712, OFF_AT = 68096, OFF_BT = 77312, OFF_KT = 86528, OFF_RT = 95744,
              OFF_VV = 104960, OFF_GC = 114176, OFF_PAR = 115200, OFF_Y = 118272, OFF_END = 134656;
constexpr int OFF_RAW = OFF_LW;
enum { P_MR = 0, P_MK, P_MV, P_MW, P_MA, P_W0, P_A0, P_KK, P_KA, P_RK, P_GG, P_GB };
typedef short v4i16_t __attribute__((ext_vector_type(4)));
__device__ __forceinline__ v2u trread(const unsigned char* p) { const v4i16_t t = __builtin_amdgcn_ds_read_tr16_b64_v4i16((__attribute__((address_space(3))) v4i16_t*)p); return __builtin_bit_cast(v2u, t); }
typedef float f32x2_t __attribute__((ext_vector_type(2))); typedef __bf16 bf16x2_t __attribute__((ext_vector_type(2)));
__device__ __forceinline__ unsigned cvtpk(float lo, float hi) { f32x2_t v = {lo, hi}; bf16x2_t b = __builtin_convertvector(v, bf16x2_t); return __builtin_bit_cast(unsigned, b); }
__device__ __forceinline__ float sgm(float v) { return __builtin_amdgcn_rcpf(1.f + __expf(-v)); }
__device__ __forceinline__ float tanh_(float x) { const float e = __expf(2.f * x); return 1.f - 2.f * __builtin_amdgcn_rcpf(e + 1.f); }
__device__ __forceinline__ bf16x8 mkfrag(const f32x4& lo, const f32x4& hi) { v4u w; w.x = cvtpk(lo[0], lo[1]); w.y = cvtpk(lo[2], lo[3]); w.z = cvtpk(hi[0], hi[1]); w.w = cvtpk(hi[2], hi[3]); return __builtin_bit_cast(bf16x8, w); }
__device__ __forceinline__ bf16x8 mkfrag_lo(const f32x4& lo) { v4u w; w.x = cvtpk(lo[0], lo[1]); w.y = cvtpk(lo[2], lo[3]); w.z = 0u; w.w = 0u; return __builtin_bit_cast(bf16x8, w); }
#define MFMA16(a, b, c) __builtin_amdgcn_mfma_f32_16x16x32_bf16((a), (b), (c), 0, 0, 0)
__device__ __forceinline__ void unpack8(const v4u& w, float (&o)[8]) { o[0] = bflo(w.x); o[1] = bfhi(w.x); o[2] = bflo(w.y); o[3] = bfhi(w.y); o[4] = bflo(w.z); o[5] = bfhi(w.z); o[6] = bflo(w.w); o[7] = bfhi(w.w); }
__device__ __forceinline__ v4u pack8(const float (&o)[8]) { v4u w; w.x = cvtpk(o[0], o[1]); w.y = cvtpk(o[2], o[3]); w.z = cvtpk(o[4], o[5]); w.w = cvtpk(o[6], o[7]); return w; }

__device__ __forceinline__ void rwkv_head(unsigned char* lds, const Args& A, const bf16* Z, bf16* YA, int b, int h) {
    const int tid = threadIdx.x, lane = tid & 63, r32 = lane & 31, hi = lane >> 5; const int wid = __builtin_amdgcn_readfirstlane(tid >> 6);
    const bf16* WUPt = (const bf16*)(A.ws + WS_WUP); const bf16* AUPt = (const bf16*)(A.ws + WS_AUP);
    const int tok = tid >> 3, cg = tid & 7, c0 = 8 * cg, hc = h * 64 + c0;
    bf16x8 wf[4];
    { const bf16* WT = (wid >> 2) ? AUPt : WUPt; const bf16* wp = WT + (size_t)(h * 64 + (wid & 1) * 32 + r32) * 64 + hi * 8;
#pragma unroll
      for (int s = 0; s < 4; ++s) wf[s] = *(const bf16x8*)(wp + 16 * s); }
    const int c15 = lane & 15, g = lane >> 4;
    f32x4 H[4];
#pragma unroll
    for (int j = 0; j < 4; ++j) H[j] = (f32x4){0.f, 0.f, 0.f, 0.f};
    const size_t rowbase = (size_t)b * SEQ;
    float* sLG = (float*)(lds + OFF_LG); float* sY = (float*)(lds + OFF_Y); float* sGC = (float*)(lds + OFF_GC); float* sPar = (float*)(lds + OFF_PAR);
    __syncthreads();
    if (tid < 64) { const int c = tid, hcc = h * 64 + c;
        sPar[P_MR * 64 + c] = A.shift_mix[hcc]; sPar[P_MK * 64 + c] = A.shift_mix[1024 + hcc]; sPar[P_MV * 64 + c] = A.shift_mix[2048 + hcc]; sPar[P_MW * 64 + c] = A.shift_mix[3072 + c]; sPar[P_MA * 64 + c] = A.shift_mix[3136 + c];
        sPar[P_W0 * 64 + c] = A.w0[hcc]; sPar[P_A0 * 64 + c] = A.a0[hcc]; sPar[P_KK * 64 + c] = A.k_k[hcc]; sPar[P_KA * 64 + c] = A.k_a[hcc]; sPar[P_RK * 64 + c] = A.r_k[hcc]; sPar[P_GG * 64 + c] = A.gn_g[hcc]; sPar[P_GB * 64 + c] = A.gn_b[hcc]; }
#define RAW_DMA(t_first) do { for (int i_ = wid; i_ < 45; i_ += 8) { const int a_ = i_ / 9, gr_ = i_ % 9; \
        const int col_ = (a_ == 0 ? ZC_R + h * 64 : a_ == 1 ? ZC_KA + h * 64 : a_ == 2 ? ZC_VA + h * 64 : a_ == 3 ? ZC_WD : ZC_AD) + (lane & 7) * 8; \
        const bf16* src_ = Z + ((long)rowbase + (t_first) - 1 + 8 * gr_ + (lane >> 3)) * ZP + col_; \
        __builtin_amdgcn_global_load_lds((const unsigned*)src_, (__attribute__((address_space(3))) unsigned*)(lds + OFF_RAW + i_ * 1024), 16, 0, 0); } } while (0)
    RAW_DMA(0);
    asm volatile("s_waitcnt vmcnt(0)" ::: "memory");
    __syncthreads();
    for (int t0 = 0; t0 < SEQ; t0 += SC) {
        const int t = t0 + tok;
        float r[8], k[8], v[8];
        {
            float wd[8], ad[8], cur[8], prv[8];
            const v4u zero4 = {0u, 0u, 0u, 0u};
#define RAWP(a, rho) (lds + OFF_RAW + ((a) * 9 + ((rho) >> 3)) * 1024 + ((rho) & 7) * 128 + cg * 16)
#define SHF8(dst, a, prow) do { unpack8(*(const v4u*)RAWP(a, tok + 1), cur); unpack8(t > 0 ? *(const v4u*)RAWP(a, tok) : zero4, prv); \
            const f32x4 m0 = *(const f32x4*)(sPar + (prow) * 64 + c0), m1 = *(const f32x4*)(sPar + (prow) * 64 + c0 + 4); \
            _Pragma("unroll") for (int i = 0; i < 4; ++i) { dst[i] = cur[i] + (prv[i] - cur[i]) * m0[i]; dst[4 + i] = cur[4 + i] + (prv[4 + i] - cur[4 + i]) * m1[i]; } } while (0)
            SHF8(r, 0, P_MR); SHF8(k, 1, P_MK); SHF8(v, 2, P_MV); SHF8(wd, 3, P_MW); SHF8(ad, 4, P_MA);
#undef SHF8
#undef RAWP
#pragma unroll
            for (int i = 0; i < 8; ++i) wd[i] = tanh_(wd[i]);
            *(v4u*)(lds + OFF_TW + tok * PB + c0 * 2) = pack8(wd); *(v4u*)(lds + OFF_AD + tok * PB + c0 * 2) = pack8(ad);
        }
        __syncthreads();
        {
            const unsigned char* ap = lds + ((wid >> 2) ? OFF_AD : OFF_TW) + (((wid >> 1) & 1) * 32 + r32) * PB + hi * 16;
            f32x16 acc;
#pragma unroll
            for (int i = 0; i < 16; ++i) acc[i] = 0.f;
#pragma unroll
            for (int s = 0; s < 4; ++s) { const bf16x8 af = *(const bf16x8*)(ap + 32 * s); acc = __builtin_amdgcn_mfma_f32_32x32x16_bf16(af, wf[s], acc, 0, 0, 0); }
            float* dst = (float*)(lds + ((wid >> 2) ? OFF_LA : OFF_LW)) + (((wid >> 1) & 1) * 32) * 65 + (wid & 1) * 32 + r32;
#pragma unroll
            for (int i = 0; i < 16; ++i) dst[crow(i, hi) * 65] = acc[i];
        }
        __syncthreads();
        float lg[8], nk[8], bb[8], kp[8]; float rkb;
        {
            const float* sLW = (const float*)(lds + OFF_LW) + tok * 65 + c0; const float* sLA = (const float*)(lds + OFF_LA) + tok * 65 + c0;
            float av[8], kk[8]; float ss = 0.f;
            const f32x4 w0a = *(const f32x4*)(sPar + P_W0 * 64 + c0), w0b = *(const f32x4*)(sPar + P_W0 * 64 + c0 + 4), a0a = *(const f32x4*)(sPar + P_A0 * 64 + c0), a0b = *(const f32x4*)(sPar + P_A0 * 64 + c0 + 4);
            const f32x4 kka = *(const f32x4*)(sPar + P_KK * 64 + c0), kkb = *(const f32x4*)(sPar + P_KK * 64 + c0 + 4), kaa = *(const f32x4*)(sPar + P_KA * 64 + c0), kab = *(const f32x4*)(sPar + P_KA * 64 + c0 + 4);
            const f32x4 rka = *(const f32x4*)(sPar + P_RK * 64 + c0), rkc = *(const f32x4*)(sPar + P_RK * 64 + c0 + 4);
#pragma unroll
            for (int i = 0; i < 8; ++i) { const float pw0 = i < 4 ? w0a[i & 3] : w0b[i & 3], pa0 = i < 4 ? a0a[i & 3] : a0b[i & 3], pkk = i < 4 ? kka[i & 3] : kkb[i & 3], pka = i < 4 ? kaa[i & 3] : kab[i & 3];
                lg[i] = -0.6065306597126334f * sgm(pw0 + sLW[i]); av[i] = sgm(pa0 + sLA[i]); kk[i] = k[i] * pkk; ss += kk[i] * kk[i]; kp[i] = k[i] * (1.f + (av[i] - 1.f) * pka); }
            ss = red8(ss); const float inv = __builtin_amdgcn_rsqf(ss + 1e-12f);
            float rk = 0.f;
#pragma unroll
            for (int i = 0; i < 8; ++i) { const float kn = kk[i] * inv; nk[i] = -kn; bb[i] = kn * av[i]; rk += r[i] * kp[i] * (i < 4 ? rka[i & 3] : rkc[i & 3]); }
            rkb = red8(rk);
            *(f32x4*)(sLG + tok * 64 + c0) = (f32x4){lg[0], lg[1], lg[2], lg[3]}; *(f32x4*)(sLG + tok * 64 + c0 + 4) = (f32x4){lg[4], lg[5], lg[6], lg[7]};
        }
        __syncthreads();
        if (tid < 256) { float* col = sLG + (tid >> 6) * 16 * 64 + (tid & 63); float x[16];
#pragma unroll
            for (int u = 0; u < 16; ++u) x[u] = col[u * 64];
#pragma unroll
            for (int u = 1; u < 16; ++u) x[u] += x[u - 1];
#pragma unroll
            for (int u = 1; u < 16; ++u) col[u * 64] = x[u]; }
        __syncthreads();
        {
            float Li[8], Lt[8];
            const int tb = tok & ~15, tl = tok & 15;
            { const f32x4 x0 = *(const f32x4*)(sLG + tok * 64 + c0), x1 = *(const f32x4*)(sLG + tok * 64 + c0 + 4), y0 = *(const f32x4*)(sLG + (tb + 15) * 64 + c0), y1 = *(const f32x4*)(sLG + (tb + 15) * 64 + c0 + 4);
#pragma unroll
              for (int i = 0; i < 4; ++i) { Li[i] = x0[i]; Li[4 + i] = x1[i]; Lt[i] = y0[i]; Lt[4 + i] = y1[i]; } }
            float oa[8], ob[8], ok[8], orr[8];
#pragma unroll
            for (int i = 0; i < 8; ++i) { const float et = __expf(Li[i]), em = __expf(Li[i] - lg[i]), en = __builtin_amdgcn_rcpf(et);
                oa[i] = nk[i] * em; ob[i] = bb[i] * en; ok[i] = kp[i] * en; orr[i] = r[i] * et; }
            *(v4u*)(lds + OFF_AT + tok * PB + c0 * 2) = pack8(oa); *(v4u*)(lds + OFF_BT + tok * PB + c0 * 2) = pack8(ob);
            *(v4u*)(lds + OFF_KT + tok * PB + c0 * 2) = pack8(ok); *(v4u*)(lds + OFF_RT + tok * PB + c0 * 2) = pack8(orr);
            *(v4u*)(lds + OFF_VV + tok * PB + c0 * 2) = pack8(v);
            if (tl == 15) {
#pragma unroll
                for (int i = 0; i < 8; ++i) sGC[(tok >> 4) * 64 + c0 + i] = __expf(Lt[i]); }
        }
        __syncthreads();
        if (t0 + SC < SEQ) RAW_DMA(t0 + SC);
#define FRAGP(c, f) (lds + ((c) < 3 ? (c) * 6144 : OFF_END) + (f) * 1024 + lane * 16)
        if (wid < 4) {
            const f32x4 z4 = {0.f, 0.f, 0.f, 0.f};
            const int tok0 = 16 * wid;
            const unsigned char* rowp = lds + (tok0 + c15) * PB;
            bf16x8 fa[2], fb[2], fk[2], fr[2];
#pragma unroll
            for (int ks = 0; ks < 2; ++ks) { fa[ks] = *(const bf16x8*)(rowp + OFF_AT + 64 * ks + 16 * g); fb[ks] = *(const bf16x8*)(rowp + OFF_BT + 64 * ks + 16 * g);
                fk[ks] = *(const bf16x8*)(rowp + OFF_KT + 64 * ks + 16 * g); fr[ks] = *(const bf16x8*)(rowp + OFF_RT + 64 * ks + 16 * g); }
            f32x4 Aab = MFMA16(fa[0], fb[0], z4); Aab = MFMA16(fa[1], fb[1], Aab);
            f32x4 AabT = MFMA16(fb[0], fa[0], z4); AabT = MFMA16(fb[1], fa[1], AabT);
            f32x4 AakT = MFMA16(fk[0], fa[0], z4); AakT = MFMA16(fk[1], fa[1], AakT);
            f32x4 ArbT = MFMA16(fb[0], fr[0], z4); ArbT = MFMA16(fb[1], fr[1], ArbT);
            f32x4 ArkT = MFMA16(fk[0], fr[0], z4); ArkT = MFMA16(fk[1], fr[1], ArkT);
#pragma unroll
            for (int rr = 0; rr < 4; ++rr) { const int row = 4 * g + rr;
                if (!(c15 < row)) Aab[rr] = 0.f;
                if (!(row < c15)) { AabT[rr] = 0.f; AakT[rr] = 0.f; }
                if (!(row <= c15)) { ArbT[rr] = 0.f; ArkT[rr] = 0.f; } }
            const bf16x8 fA = mkfrag_lo(Aab), fAT = mkfrag_lo(AabT);
            const f32x4 A2 = MFMA16(fAT, fA, z4), A2T = MFMA16(fA, fAT, z4);
            const bf16x8 fA2 = mkfrag_lo(A2), fA2T = mkfrag_lo(A2T);
            const f32x4 A4 = MFMA16(fA2T, fA2, z4), A4T = MFMA16(fA2, fA2T, z4);
            const bf16x8 fA4 = mkfrag_lo(A4), fA4T = mkfrag_lo(A4T);
            const f32x4 A8T = MFMA16(fA4, fA4T, z4);
            *(bf16x8*)FRAGP(wid, 0) = fAT; *(bf16x8*)FRAGP(wid, 1) = fA2T; *(bf16x8*)FRAGP(wid, 2) = fA4T; *(bf16x8*)FRAGP(wid, 3) = mkfrag_lo(A8T);
            *(bf16x8*)FRAGP(wid, 4) = mkfrag_lo(AakT); *(bf16x8*)FRAGP(wid, 5) = mkfrag(ArbT, ArkT);
        }
        __syncthreads();
        if (wid < 4) {
            const f32x4 z4 = {0.f, 0.f, 0.f, 0.f};
#pragma unroll 1
            for (int ch = 0; ch < 4; ++ch) {
                const int tok0 = 16 * ch;
                const unsigned char* rowp = lds + (tok0 + c15) * PB;
                const unsigned char* fp = lds + (ch < 3 ? ch * 6144 : OFF_END) + lane * 16;
                const bf16x8 fAT = *(const bf16x8*)(fp), fA2T = *(const bf16x8*)(fp + 1024), fA4T = *(const bf16x8*)(fp + 2048), fA8T = *(const bf16x8*)(fp + 3072), fAkT = *(const bf16x8*)(fp + 4096), fArbk = *(const bf16x8*)(fp + 5120);
                const bf16x8 Hb0 = mkfrag(H[0], H[1]), Hb1 = mkfrag(H[2], H[3]);
                bf16x8 pa[2], pr[2];
#pragma unroll
                for (int ks = 0; ks < 2; ++ks) { const v2u a_lo = *(const v2u*)(rowp + OFF_AT + 64 * ks + 8 * g), a_hi = *(const v2u*)(rowp + OFF_AT + 64 * ks + 32 + 8 * g);
                    const v2u r_lo = *(const v2u*)(rowp + OFF_RT + 64 * ks + 8 * g), r_hi = *(const v2u*)(rowp + OFF_RT + 64 * ks + 32 + 8 * g);
                    pa[ks] = __builtin_bit_cast(bf16x8, (v4u){a_lo.x, a_lo.y, a_hi.x, a_hi.y}); pr[ks] = __builtin_bit_cast(bf16x8, (v4u){r_lo.x, r_lo.y, r_hi.x, r_hi.y}); }
                f32x4 X = MFMA16(pa[0], Hb0, z4); X = MFMA16(pa[1], Hb1, X);
                const unsigned char* trp = lds + (tok0 + 4 * g + (c15 >> 2)) * PB + 8 * (c15 & 3);
                const v2u vv = trread(trp + OFF_VV + 32 * wid);
                const bf16x8 Vb = __builtin_bit_cast(bf16x8, (v4u){vv.x, vv.y, 0u, 0u});
                X = MFMA16(fAkT, Vb, X);
                X = MFMA16(fA8T, mkfrag_lo(X), X); X = MFMA16(fA4T, mkfrag_lo(X), X); X = MFMA16(fA2T, mkfrag_lo(X), X); X = MFMA16(fAT, mkfrag_lo(X), X);
                const bf16x8 UVb = __builtin_bit_cast(bf16x8, (v4u){cvtpk(X[0], X[1]), cvtpk(X[2], X[3]), vv.x, vv.y});
                f32x4 Y = MFMA16(pr[0], Hb0, z4); Y = MFMA16(pr[1], Hb1, Y);
                Y = MFMA16(fArbk, UVb, Y);
#pragma unroll
                for (int rr = 0; rr < 4; ++rr) sY[(tok0 + 4 * g + rr) * 64 + 16 * wid + c15] = Y[rr];
#pragma unroll
                for (int jt = 0; jt < 4; ++jt) { const v2u bl = trread(trp + OFF_BT + 32 * jt), kl = trread(trp + OFF_KT + 32 * jt);
                    const bf16x8 fBK = __builtin_bit_cast(bf16x8, (v4u){bl.x, bl.y, kl.x, kl.y});
                    const f32x4 gc = *(const f32x4*)(sGC + ch * 64 + 16 * jt + 4 * g);
                    H[jt] = MFMA16(fBK, UVb, H[jt]) * gc; }
            }
        }
#undef FRAGP
        asm volatile("s_waitcnt vmcnt(0)" ::: "memory");
        __syncthreads();
        {
            const f32x4 ya = *(const f32x4*)(sY + tok * 64 + c0), yb = *(const f32x4*)(sY + tok * 64 + c0 + 4);
            float y[8] = {ya[0], ya[1], ya[2], ya[3], yb[0], yb[1], yb[2], yb[3]};
            float s = 0.f;
#pragma unroll
            for (int i = 0; i < 8; ++i) s += y[i];
            const float mu = red8(s) * (1.f / 64.f); float q = 0.f;
#pragma unroll
            for (int i = 0; i < 8; ++i) { y[i] -= mu; q += y[i] * y[i]; }
            const float rs = 1.f / sqrtf(red8(q) * (1.f / 64.f) + 64e-5f);
            const f32x4 gga = *(const f32x4*)(sPar + P_GG * 64 + c0), ggb = *(const f32x4*)(sPar + P_GG * 64 + c0 + 4), gba = *(const f32x4*)(sPar + P_GB * 64 + c0), gbb = *(const f32x4*)(sPar + P_GB * 64 + c0 + 4);
            float o[8];
#pragma unroll
            for (int i = 0; i < 8; ++i) o[i] = y[i] * rs * (i < 4 ? gga[i & 3] : ggb[i & 3]) + (i < 4 ? gba[i & 3] : gbb[i & 3]) + rkb * v[i];
            *(v4u*)(YA + (rowbase + t) * DM + hc) = pack8(o);
        }
    }
}
#undef MFMA16
#undef RAW_DMA
}


#define LAS __attribute__((address_space(3)))
#define XB_TMO      128
#define XB_XCNT(j)  (256  + 64 * (j))
#define XB_XSUB(j)  (1280 + 64 * (j))
#define XB_XGEN(j)  (2304 + 64 * (j))
#define XB_TOP      3328
#define XB_TOPGEN   3392
#define XCD_BAR_WORDS 3456
#define XB_SPIN_CAP (1u << 18)

__device__ __forceinline__ unsigned xb_ld(unsigned* p)              { return __hip_atomic_load(p, __ATOMIC_RELAXED, __HIP_MEMORY_SCOPE_AGENT); }
__device__ __forceinline__ unsigned xb_add(unsigned* p, unsigned v) { return __hip_atomic_fetch_add(p, v, __ATOMIC_RELAXED, __HIP_MEMORY_SCOPE_AGENT); }
__device__ __forceinline__ unsigned xb_xcc_id() { return (unsigned)__builtin_amdgcn_s_getreg((3 << 11) | 20) & 0xFu; }
#define XB_SPIN(cond, bar) do { unsigned _sp = 0; while (cond) { __builtin_amdgcn_s_sleep(1); \
    if ((++_sp & 255u) == 0u) { if (xb_ld(&(bar)[XB_TMO])) break; if (_sp > XB_SPIN_CAP) { atomicAdd(&(bar)[XB_TMO], 1u); break; } } } } while (0)

struct XcdBarrier {
    unsigned* bar; unsigned x;
    volatile LAS unsigned* st;
};

__device__ __forceinline__ XcdBarrier xcd_barrier_post(unsigned* bar, volatile LAS unsigned* st) {
    XcdBarrier b; b.bar = bar; b.x = xb_xcc_id(); b.st = st;
    if (threadIdx.x == 0) (void)xb_add(&bar[XB_XCNT(b.x)], 1u);
    return b;
}
__device__ __forceinline__ void xcd_barrier_complete(unsigned* bar, unsigned x, unsigned& nloc, unsigned& nx) {
    const unsigned G = gridDim.x * gridDim.y * gridDim.z;
    unsigned sum, cnt, mine, sp = 0u;
    for (;;) {
        sum = 0u; cnt = 0u; mine = 0u;
#pragma unroll
        for (unsigned j = 0; j < 16; ++j) { const unsigned c = xb_ld(&bar[XB_XCNT(j)]); sum += c; cnt += (c > 0u) ? 1u : 0u; mine = (j == x) ? c : mine; }
        if (sum == G) break;
        __builtin_amdgcn_s_sleep(1);
        if ((++sp & 255u) == 0u) { if (xb_ld(&bar[XB_TMO])) break; if (sp > XB_SPIN_CAP) { atomicAdd(&bar[XB_TMO], 1u); break; } }
    }
    nloc = mine > 0u ? mine : 1u; nx = cnt > 0u ? cnt : 1u;
}

__device__ __forceinline__ void xcd_barrier(const XcdBarrier& b) {
    asm volatile("s_waitcnt vmcnt(0)" ::: "memory");
    __syncthreads();
    if (threadIdx.x == 0) {
        unsigned* bar = b.bar;
        __builtin_amdgcn_s_waitcnt(0);
        unsigned nloc = b.st[0], nx = b.st[1];
        if (nloc == 0u) { xcd_barrier_complete(bar, b.x, nloc, nx); b.st[0] = nloc; b.st[1] = nx; }
        const unsigned old = xb_add(&bar[XB_XSUB(b.x)], 1u);
        const unsigned gen = old / nloc;
        if (old + 1u == (gen + 1u) * nloc) {
            __builtin_amdgcn_fence(__ATOMIC_RELEASE, "agent");
            asm volatile("s_waitcnt vmcnt(0)" ::: "memory");
            const unsigned og = xb_add(&bar[XB_TOP], 1u);
            const unsigned tg = og / nx;
            if (og + 1u == (tg + 1u) * nx) xb_add(&bar[XB_TOPGEN], 1u);
            else XB_SPIN(xb_ld(&bar[XB_TOPGEN]) == tg, bar);
            __builtin_amdgcn_fence(__ATOMIC_ACQUIRE, "agent");
            xb_add(&bar[XB_XGEN(b.x)], 1u);
            asm volatile("s_waitcnt vmcnt(0)" ::: "memory");
        } else {
            XB_SPIN(xb_ld(&bar[XB_XGEN(b.x)]) == gen, bar);
            __builtin_amdgcn_fence(__ATOMIC_ACQUIRE, "agent");
            asm volatile("s_waitcnt vmcnt(0)" ::: "memory");
        }
    }
    __syncthreads();
}

constexpr int N_PHASES = 10;
template <bool COOP>
__global__ void __launch_bounds__(NWAVES * 64, 2) fwd_kernel(Args A) {
    extern __shared__ __attribute__((aligned(16))) unsigned char lds[];
    const int tid = threadIdx.x, lane = tid & 63; const int wave = __builtin_amdgcn_readfirstlane(tid >> 6);
    const int G = gridDim.x, bid = blockIdx.x;
    unsigned char* ws = A.ws;
    bf16* WIN_T = (bf16*)(ws + WS_WIN);
    bf16* Z = (bf16*)(ws + WS_Z); bf16* Vt = (bf16*)(ws + WS_VT);
    bf16* XN = (bf16*)((unsigned char*)A.out + DO_XN); bf16* YA = (bf16*)((unsigned char*)A.out + DO_YA);
    bf16* TM = XN;
    bf16* HP = YA;
    float* X1 = (float*)(ws + WS_X1); float* PE = (float*)(ws + WS_PE);
    PG8_LAS unsigned char* ldsg = (PG8_LAS unsigned char*)lds;
    const int lo = A.ph_lo, hi = A.ph_hi;
    if (COOP && A.pad == 0x7fffffff) cg::this_grid().sync();
    XcdBarrier bar; bar.bar = (unsigned*)(ws + WS_CTL) + CW_BAR; bar.x = 0; bar.st = nullptr;
    if (COOP) {
        volatile LAS unsigned* MISC = (volatile LAS unsigned*)((LAS unsigned char*)lds + MISC_OFF);
        if (tid < 32) MISC[tid] = 0u;
        __syncthreads();
        bar = xcd_barrier_post((unsigned*)(ws + WS_CTL) + CW_BAR, MISC + 8);
    }
#define IN(k) (lo <= (k) && (k) < hi)
#define SEAM(k) do { if (COOP && IN(k) && IN((k) + 1)) { xcd_barrier(bar); } } while (0)

    if (IN(0)) { p0_prologue(A, lds, G, bid); }
    SEAM(0);
    if (IN(1)) {
        pg8::Gemm g{XN, WIN_T, MTOK, N1, DM, DM}; pg8::StaticOrder S; S.init(MTOK, N1, G, bid);
        pg8::EpiZ1 E{Z, Vt, (const float*)(ws + WS_COS), (const float*)(ws + WS_SIN)};
        pg8::gemm_phase<pg8::EpiZ1, pg8::StaticOrder, true, true>(ldsg, g, S, E);
    }
    SEAM(1);
    if (IN(2)) {
        for (int hd = bid; hd < NB * 16; hd += G) rwkv::rwkv_head(lds, A, Z, YA, hd >> 4, hd & 15);
        __syncthreads();
        float lam;
        { const float* lv = A.diff_lam; const float s01 = wave_sum(lv[lane] * lv[64 + lane]), s23 = wave_sum(lv[128 + lane] * lv[192 + lane]); lam = __expf(s01) - __expf(s23) + LAMBDA_INIT; }
        unsigned* ctr = (unsigned*)(ws + WS_CTL) + CW_ATT;
        for (;;) {
            if (tid == 0) *(volatile unsigned*)(lds + att::OFF_Q) = atomicAdd(ctr, 1u);
            __syncthreads();
            const unsigned u = *(volatile unsigned*)(lds + att::OFF_Q);
            __syncthreads();
            if (u >= (unsigned)(NB * 8 * 16)) break;
            const int qb = 15 - (int)(u >> 6), bh = (int)(u & 63);
            att::attn_unit(lds, Z, Vt, Z, bh >> 3, bh & 7, qb, lam, A.subln_g);
        }
    }
    SEAM(2);
    if (IN(3)) {
        pg8::Gemm g{XN, WIN_T + (size_t)N1 * DM, MTOK, N2, DM, DM}; pg8::StaticOrder S; S.init(MTOK, N2, G, bid);
        pg8::EpiGates E{YA, Z};
        pg8::gemm_phase<pg8::EpiGates, pg8::StaticOrder, true, true>(ldsg, g, S, E);
    }
    SEAM(3);
    if (IN(4)) {
        pg8::Gemm g{YA, (const bf16*)(ws + WS_PA), MTOK, DM, DM, DM}; pg8::StaticOrder S; S.init(MTOK, DM, G, bid);
        pg8::EpiBranch<0> E{TM, Z, ZC_K};
        pg8::gemm_phase<pg8::EpiBranch<0>, pg8::StaticOrder, true, true>(ldsg, g, S, E);
    }
    SEAM(4);
    if (IN(5)) {
        pg8::Gemm g{Z + ZC_Q, (const bf16*)(ws + WS_PB), MTOK, DM, DM, ZP}; pg8::StaticOrder S; S.init(MTOK, DM, G, bid);
        pg8::EpiBranch<1> E{TM, Z, ZC_R};
        pg8::gemm_phase<pg8::EpiBranch<1>, pg8::StaticOrder, true, true>(ldsg, g, S, E);
    }
    SEAM(5);
    if (IN(6)) {
        { pg8::Gemm g{TM, (const bf16*)(ws + WS_WO), MTOK, DM, DM, DM}; pg8::StaticOrder S; S.init(MTOK, DM, G, bid);
          pg8::EpiF32<1> E{X1, A.x};
          pg8::gemm_phase<pg8::EpiF32<1>, pg8::StaticOrder, true, true>(ldsg, g, S, E); }
        { pg8::Gemm g{(const bf16*)(ws + WS_PBF), (const bf16*)(ws + WS_WPE), MTOK, DM, PLE, PLE}; pg8::StaticOrder S; S.init(MTOK, DM, G, bid);
          pg8::EpiF32<0> E{PE, nullptr};
          pg8::gemm_phase<pg8::EpiF32<0>, pg8::StaticOrder, true, true>(ldsg, g, S, E); }
    }
    SEAM(6);
    if (IN(7)) {
        const int gw = bid * NWAVES + wave, NGW = G * NWAVES;
        for (int m = gw; m < MTOK; m += NGW) rms_row_to_bf16(X1 + (size_t)m * DM, A.ple_norm_g, HP + (size_t)m * DM, lane);
    }
    SEAM(7);
    if (IN(8)) {
        pg8::Gemm g{HP, (const bf16*)(ws + WS_WPG), MTOK, DM, DM, DM}; pg8::StaticOrder S; S.init(MTOK, DM, G, bid);
        pg8::EpiF32<2> E{X1, PE};
        pg8::gemm_phase<pg8::EpiF32<2>, pg8::StaticOrder, true, true>(ldsg, g, S, E);
    }
    SEAM(8);
    if (IN(9)) {
        const int gw = bid * NWAVES + wave, NGW = G * NWAVES;
        for (int m = gw; m < MTOK; m += NGW) rms_row_to_f32(X1 + (size_t)m * DM, A.final_g, A.out + (size_t)m * DM, lane);
    }
#undef IN
#undef SEAM
}

#ifndef MK_N_LAUNCHES
#define MK_N_LAUNCHES 1
#endif
extern "C" void kernel_launch(void* const* d_in, const int* in_sizes, int n_in, void* d_out, int out_size, void* d_ws, size_t ws_size, hipStream_t stream) {
    static int grid = 0;
    if (grid == 0) {
        if (n_in != 23 || in_sizes[0] != MTOK * DM || out_size != MTOK * DM || ws_size < WS_END) { fprintf(stderr, "kernel_launch: unexpected shapes (n_in %d, in0 %d, out %d, ws %zu)\n", n_in, n_in > 0 ? in_sizes[0] : -1, out_size, ws_size); grid = -1; return; }
        int dev = 0, cus = 0;
        if (hipGetDevice(&dev) != hipSuccess || hipDeviceGetAttribute(&cus, hipDeviceAttributeMultiprocessorCount, dev) != hipSuccess) { grid = -1; return; }
        if (hipFuncSetAttribute((const void*)fwd_kernel<(MK_N_LAUNCHES == 1)>, hipFuncAttributeMaxDynamicSharedMemorySize, LDS_BYTES) != hipSuccess) { fprintf(stderr, "kernel_launch: hipFuncSetAttribute failed\n"); grid = -1; return; }
        int per_cu = 0;
        if (hipOccupancyMaxActiveBlocksPerMultiprocessor(&per_cu, (const void*)fwd_kernel<(MK_N_LAUNCHES == 1)>, NWAVES * 64, LDS_BYTES) != hipSuccess || per_cu < 1) { fprintf(stderr, "kernel_launch: occupancy query says %d\n", per_cu); }
        (void)hipGetLastError();
        grid = cus;
    }
    if (grid < 0) return;
    (void)hipMemsetAsync((char*)d_ws + WS_CTL, 0, CTL_ZERO_BYTES, stream);
    Args a{};
    a.x = (const float*)d_in[0]; a.p = (const float*)d_in[1]; a.pos = (const int*)d_in[2]; a.norm_g = (const float*)d_in[3]; a.w_in = (const float*)d_in[4];
    a.shift_mix = (const float*)d_in[5]; a.w0 = (const float*)d_in[6]; a.w_up = (const float*)d_in[7]; a.a0 = (const float*)d_in[8]; a.a_up = (const float*)d_in[9];
    a.k_k = (const float*)d_in[10]; a.k_a = (const float*)d_in[11]; a.r_k = (const float*)d_in[12]; a.gn_g = (const float*)d_in[13]; a.gn_b = (const float*)d_in[14];
    a.diff_lam = (const float*)d_in[15]; a.subln_g = (const float*)d_in[16]; a.w_branch = (const float*)d_in[17]; a.w_out = (const float*)d_in[18];
    a.ple_norm_g = (const float*)d_in[19]; a.w_pg = (const float*)d_in[20]; a.w_pe = (const float*)d_in[21]; a.final_g = (const float*)d_in[22];
    a.out = (float*)d_out; a.ws = (unsigned char*)d_ws; a.pad = 0;
#if MK_N_LAUNCHES == 1
    a.ph_lo = 0; a.ph_hi = N_PHASES; a.coop = 1;
    void* args[] = {&a};
    hipError_t e = hipLaunchCooperativeKernel((const void*)fwd_kernel<true>, dim3(grid), dim3(NWAVES * 64), args, LDS_BYTES, stream);
    if (e != hipSuccess) fprintf(stderr, "kernel_launch: cooperative launch failed: %s (grid %d)\n", hipGetErrorString(e), grid);
#else
    for (int ph = 0; ph < N_PHASES; ++ph) { a.ph_lo = ph; a.ph_hi = ph + 1; a.coop = 0;
        hipLaunchKernelGGL(fwd_kernel<false>, dim3(grid), dim3(NWAVES * 64), LDS_BYTES, stream, a); }
#endif
}
```
